# Optimizing an MI355X kernel written in HIP

```python
import jax, jax.numpy as jnp
from jax import lax
import numpy as np

D_MODEL = 1024
BATCH = 4
SEQ = 4096
DEPTH = 2

CHUNK = 64
N_A_LAYERS = DEPTH // 2
N_B_LAYERS = DEPTH - N_A_LAYERS
A_WIDTH = 2 * D_MODEL
A_GROUP_LEN = 128
A_HEAD_CH = 128
A_HEADS = A_WIDTH // A_HEAD_CH
B_HEAD_DIM = 64
B_HEADS = D_MODEL // B_HEAD_DIM
B_WIDTH = B_HEADS * B_HEAD_DIM
B_PREV_CHUNKS = 8
B_BAND = (B_PREV_CHUNKS + 1) * CHUNK
B_LEFT_PAD = B_PREV_CHUNKS * CHUNK
REL_CLIP = 256
N_REL = 2 * REL_CLIP + 1
EPS = 1e-6
NEG_INF = -1e30

kernel_name = "yoco_gmlp_chunkattn_hybrid"


def rms_norm(x, g):
    xf = x.astype(jnp.float32)
    y = xf * lax.rsqrt(jnp.mean(xf * xf, axis=-1, keepdims=True) + EPS)
    return (y * g.astype(jnp.float32)).astype(x.dtype)


def layer_norm(x, g, b):
    xf = x.astype(jnp.float32)
    mu = jnp.mean(xf, axis=-1, keepdims=True)
    xc = xf - mu
    y = xc * lax.rsqrt(jnp.mean(xc * xc, axis=-1, keepdims=True) + EPS)
    return (y * g.astype(jnp.float32) + b.astype(jnp.float32)).astype(x.dtype)


def gmlp_mixer(h, w_in, ln_g, ln_b, w_s, b_s, w_out):
    bsz, s, _ = h.shape
    u, v, z = jnp.split(h @ w_in, 3, axis=-1)
    u = jax.nn.gelu(u)
    v = layer_norm(jax.nn.gelu(v), ln_g, ln_b)
    vg = v.reshape(bsz, s // A_GROUP_LEN, A_GROUP_LEN, A_HEADS, A_HEAD_CH)
    pos_chunk = jnp.arange(A_GROUP_LEN) // CHUNK
    allowed = pos_chunk[:, None] >= pos_chunk[None, :]
    w_m = jnp.where(allowed[None], w_s, jnp.zeros_like(w_s)).astype(vg.dtype)
    mixed = jnp.einsum('hts,bgshc->bgthc', w_m, vg)
    mixed = mixed + b_s.T.astype(vg.dtype)[:, :, None]
    mixed = mixed.reshape(bsz, s, A_WIDTH)
    y = u * mixed * jax.nn.silu(z)
    return y @ w_out


def shared_kv(x, g_kv, w_kv):
    bsz, s, _ = x.shape
    k, v = jnp.split(rms_norm(x, g_kv) @ w_kv, 2, axis=-1)
    pad = ((0, 0), (B_LEFT_PAD, 0), (0, 0), (0, 0))
    k = jnp.pad(k.reshape(bsz, s, B_HEADS, B_HEAD_DIM), pad)
    v = jnp.pad(v.reshape(bsz, s, B_HEADS, B_HEAD_DIM), pad)
    return k, v


def chunk_attention_mixer(h, k_pad, v_pad, w_qz, rel_bias, w_out):
    bsz, s, _ = h.shape
    n_chunks = s // CHUNK
    q, z = jnp.split(h @ w_qz, 2, axis=-1)
    scale = B_HEAD_DIM ** -0.5
    q = (q * scale).reshape(bsz, n_chunks, CHUNK, B_HEADS, B_HEAD_DIM)
    q = jnp.moveaxis(q, 1, 0)
    qi = jnp.arange(CHUNK)
    m = jnp.arange(B_BAND)
    rel = qi[:, None] - m[None, :] + B_LEFT_PAD
    idx = jnp.clip(rel, -REL_CLIP, REL_CLIP) + REL_CLIP
    bias = rel_bias[:, idx].astype(jnp.float32)

    def one_chunk(args):
        c, qc = args
        start = c * CHUNK
        kc = lax.dynamic_slice_in_dim(k_pad, start, B_BAND, axis=1)
        vc = lax.dynamic_slice_in_dim(v_pad, start, B_BAND, axis=1)
        sc = jnp.einsum('bqhd,bkhd->bhqk', qc, kc).astype(jnp.float32) + bias
        valid = (m + start) >= B_LEFT_PAD
        sc = jnp.where(valid[None, None, None, :], sc, NEG_INF)
        p = jax.nn.softmax(sc, axis=-1).astype(vc.dtype)
        return jnp.einsum('bhqk,bkhd->bqhd', p, vc)

    o = lax.map(one_chunk, (jnp.arange(n_chunks), q))
    o = jnp.moveaxis(o, 0, 1).reshape(bsz, s, B_WIDTH)
    return (o * jax.nn.silu(z)) @ w_out


def setup_inputs(seed: int = 0) -> dict:
    key = jax.random.key(seed)
    ks = jax.random.split(key, 20)
    f32 = jnp.float32
    nrm = lambda k, shp, sc: (jax.random.normal(k, shp, f32) * sc)
    x = jax.random.normal(ks[0], (BATCH, SEQ, D_MODEL), f32)
    a_norm_g = 1.0 + nrm(ks[1], (N_A_LAYERS, D_MODEL), 0.02)
    a_w_in = nrm(ks[2], (N_A_LAYERS, D_MODEL, 3 * A_WIDTH), D_MODEL ** -0.5)
    a_ln_g = 1.0 + nrm(ks[3], (N_A_LAYERS, A_WIDTH), 0.02)
    a_ln_b = nrm(ks[4], (N_A_LAYERS, A_WIDTH), 0.02)
    a_w_s = nrm(ks[5], (N_A_LAYERS, A_HEADS, A_GROUP_LEN, A_GROUP_LEN), A_GROUP_LEN ** -0.5)
    a_b_s = 1.0 + nrm(ks[6], (N_A_LAYERS, A_HEADS, A_GROUP_LEN), 0.1)
    a_w_out = nrm(ks[7], (N_A_LAYERS, A_WIDTH, D_MODEL), A_WIDTH ** -0.5)
    kv_norm_g = 1.0 + nrm(ks[8], (D_MODEL,), 0.02)
    w_kv = nrm(ks[9], (D_MODEL, 2 * B_WIDTH), D_MODEL ** -0.5)
    b_norm_g = 1.0 + nrm(ks[10], (N_B_LAYERS, D_MODEL), 0.02)
    b_w_qz = nrm(ks[11], (N_B_LAYERS, D_MODEL, 2 * B_WIDTH), D_MODEL ** -0.5)
    b_rel_bias = nrm(ks[12], (N_B_LAYERS, B_HEADS, N_REL), 0.5)
    b_w_out = nrm(ks[13], (N_B_LAYERS, B_WIDTH, D_MODEL), B_WIDTH ** -0.5)
    final_norm_g = 1.0 + nrm(ks[14], (D_MODEL,), 0.02)
    return {"x": x, "a_norm_g": a_norm_g, "a_w_in": a_w_in, "a_ln_g": a_ln_g,
            "a_ln_b": a_ln_b, "a_w_s": a_w_s, "a_b_s": a_b_s, "a_w_out": a_w_out,
            "kv_norm_g": kv_norm_g, "w_kv": w_kv, "b_norm_g": b_norm_g,
            "b_w_qz": b_w_qz, "b_rel_bias": b_rel_bias, "b_w_out": b_w_out,
            "final_norm_g": final_norm_g}


def reference(x, a_norm_g, a_w_in, a_ln_g, a_ln_b, a_w_s, a_b_s, a_w_out,
              kv_norm_g, w_kv, b_norm_g, b_w_qz, b_rel_bias, b_w_out, final_norm_g):
    k_pad = None
    v_pad = None
    for layer in range(DEPTH):
        if layer < N_A_LAYERS:
            i = layer
            h = rms_norm(x, a_norm_g[i])
            x = x + gmlp_mixer(h, a_w_in[i], a_ln_g[i], a_ln_b[i], a_w_s[i],
                               a_b_s[i], a_w_out[i])
        else:
            i = layer - N_A_LAYERS
            if i == 0:
                k_pad, v_pad = shared_kv(x, kv_norm_g, w_kv)
            h = rms_norm(x, b_norm_g[i])
            x = x + chunk_attention_mixer(h, k_pad, v_pad, b_w_qz[i],
                                          b_rel_bias[i], b_w_out[i])
    return rms_norm(x, final_norm_g)
```

```cpp
#include <hip/hip_runtime.h>
#include <cstdio>
#include <cstdint>

constexpr int D = 1024, BATCH = 4, SEQ = 4096, MB = SEQ;
constexpr int AW = 2048, NIN = 3 * AW;
constexpr int GL = 128, AH = 16, HC = 128;
constexpr int BH = 16, HD = 64, BW = 1024, CHUNK = 64, NREL = 513;
constexpr float EPS = 1e-6f;

__device__ __forceinline__ float gelu_tanh(float x) { return 0.5f * x * (1.f + tanhf(0.7978845608028654f * (x + 0.044715f * x * x * x))); }
__device__ __forceinline__ float silu_f(float x) { return x / (1.f + expf(-x)); }

__device__ __forceinline__ float block_sum(float v, float* red) {
    for (int o = 32; o > 0; o >>= 1) v += __shfl_xor(v, o);
    const int w = threadIdx.x >> 6;
    __syncthreads();
    if ((threadIdx.x & 63) == 0) red[w] = v;
    __syncthreads();
    return red[0] + red[1] + red[2] + red[3];
}

__global__ __launch_bounds__(256) void k_rmsnorm(const float* x, const float* __restrict__ g, float* out) {
    __shared__ float red[4];
    const size_t r = blockIdx.x; const int t = threadIdx.x;
    const float4 v = ((const float4*)(x + r * D))[t];
    const float ss = block_sum(v.x * v.x + v.y * v.y + v.z * v.z + v.w * v.w, red);
    const float rs = rsqrtf(ss * (1.f / D) + EPS);
    const float4 gg = ((const float4*)g)[t];
    float4 o; o.x = v.x * rs * gg.x; o.y = v.y * rs * gg.y; o.z = v.z * rs * gg.z; o.w = v.w * rs * gg.w;
    ((float4*)(out + r * D))[t] = o;
}

__global__ __launch_bounds__(256) void k_ln_v(float* __restrict__ uvz, const float* __restrict__ g, const float* __restrict__ b) {
    __shared__ float red[4];
    const size_t r = blockIdx.x; const int t = threadIdx.x;
    float4* p = (float4*)(uvz + r * NIN + AW);
    float4 a = p[t], c = p[t + 256];
    const float s = block_sum((a.x + a.y) + (a.z + a.w) + (c.x + c.y) + (c.z + c.w), red);
    const float mu = s * (1.f / AW);
    a.x -= mu; a.y -= mu; a.z -= mu; a.w -= mu; c.x -= mu; c.y -= mu; c.z -= mu; c.w -= mu;
    const float q = block_sum(a.x * a.x + a.y * a.y + a.z * a.z + a.w * a.w + c.x * c.x + c.y * c.y + c.z * c.z + c.w * c.w, red);
    const float rs = rsqrtf(q * (1.f / AW) + EPS);
    const float4 g0 = ((const float4*)g)[t], g1 = ((const float4*)g)[t + 256], b0 = ((const float4*)b)[t], b1 = ((const float4*)b)[t + 256];
    a.x = a.x * rs * g0.x + b0.x; a.y = a.y * rs * g0.y + b0.y; a.z = a.z * rs * g0.z + b0.z; a.w = a.w * rs * g0.w + b0.w;
    c.x = c.x * rs * g1.x + b1.x; c.y = c.y * rs * g1.y + b1.y; c.z = c.z * rs * g1.z + b1.z; c.w = c.w * rs * g1.w + b1.w;
    p[t] = a; p[t + 256] = c;
}

__global__ void k_mask_ws(const float* __restrict__ ws_in, float* __restrict__ wm) {
    const int i = blockIdx.x * 256 + threadIdx.x;
    const int s = i & 127, t = (i >> 7) & 127;
    wm[i] = ((t >> 6) >= (s >> 6)) ? ws_in[i] : 0.f;
}

enum { EPI_ACT1 = 0, EPI_MIX = 1, EPI_RES = 2, EPI_PLAIN = 3 };
struct GP {
    const float* A; int lda; const float* B; int ldb; float* C; int ldc; int K;
    const float* R; int ldr;
    const float* bs;
    int pad;
};
template <int EPI> __global__ __launch_bounds__(256) void k_sgemm(GP p) {
    __shared__ float As[16][132];
    __shared__ float Bs[16][132];
    const int tid = threadIdx.x, tx = tid & 15, ty = tid >> 4;
    const float* A = p.A; const float* B = p.B; float* C = p.C; const float* R = p.R;
    int row0 = blockIdx.y * 128, col0 = blockIdx.x * 128;
    int head = 0;
    if (EPI == EPI_MIX) {
        head = blockIdx.x; const int grp = blockIdx.y;
        A += (size_t)head * GL * GL; B += (size_t)grp * GL * p.ldb + head * HC; C += (size_t)grp * GL * p.ldc + head * HC; R += (size_t)grp * GL * p.ldr + head * HC;
        row0 = 0; col0 = 0;
    } else { A += (size_t)row0 * p.lda; B += col0; C += (size_t)row0 * p.ldc + col0; if (EPI == EPI_RES) R += (size_t)row0 * p.ldr + col0; }
    float acc[8][8];
#pragma unroll
    for (int i = 0; i < 8; ++i)
#pragma unroll
        for (int j = 0; j < 8; ++j) acc[i][j] = 0.f;
    const int ar = tid >> 2, ak = (tid & 3) * 4;
    const int bk = tid >> 5, bn = (tid & 31) * 4;
    for (int k0 = 0; k0 < p.K; k0 += 16) {
        const float4 a0 = *(const float4*)(A + (size_t)ar * p.lda + k0 + ak);
        const float4 a1 = *(const float4*)(A + (size_t)(ar + 64) * p.lda + k0 + ak);
        const float4 b0 = *(const float4*)(B + (size_t)(k0 + bk) * p.ldb + bn);
        const float4 b1 = *(const float4*)(B + (size_t)(k0 + bk + 8) * p.ldb + bn);
        __syncthreads();
        As[ak + 0][ar] = a0.x; As[ak + 1][ar] = a0.y; As[ak + 2][ar] = a0.z; As[ak + 3][ar] = a0.w;
        As[ak + 0][ar + 64] = a1.x; As[ak + 1][ar + 64] = a1.y; As[ak + 2][ar + 64] = a1.z; As[ak + 3][ar + 64] = a1.w;
        *(float4*)&Bs[bk][bn] = b0; *(float4*)&Bs[bk + 8][bn] = b1;
        __syncthreads();
#pragma unroll
        for (int kk = 0; kk < 16; ++kk) {
            const float4 x0 = *(const float4*)&As[kk][ty * 4], x1 = *(const float4*)&As[kk][64 + ty * 4];
            const float4 y0 = *(const float4*)&Bs[kk][tx * 4], y1 = *(const float4*)&Bs[kk][64 + tx * 4];
            const float a[8] = {x0.x, x0.y, x0.z, x0.w, x1.x, x1.y, x1.z, x1.w};
            const float b[8] = {y0.x, y0.y, y0.z, y0.w, y1.x, y1.y, y1.z, y1.w};
#pragma unroll
            for (int i = 0; i < 8; ++i)
#pragma unroll
                for (int j = 0; j < 8; ++j) acc[i][j] = fmaf(a[i], b[j], acc[i][j]);
        }
    }
#pragma unroll
    for (int i = 0; i < 8; ++i) {
        const int r = (i < 4) ? (ty * 4 + i) : (64 + ty * 4 + i - 4);
#pragma unroll
        for (int jh = 0; jh < 2; ++jh) {
            const int c = jh * 64 + tx * 4;
            float4 v = {acc[i][jh * 4 + 0], acc[i][jh * 4 + 1], acc[i][jh * 4 + 2], acc[i][jh * 4 + 3]};
            float* cp = C + (size_t)r * p.ldc + c;
            if (EPI == EPI_ACT1) {
                const int gc = col0 + c;
                if (gc < 2 * AW) { v.x = gelu_tanh(v.x); v.y = gelu_tanh(v.y); v.z = gelu_tanh(v.z); v.w = gelu_tanh(v.w); }
                else { v.x = silu_f(v.x); v.y = silu_f(v.y); v.z = silu_f(v.z); v.w = silu_f(v.w); }
            } else if (EPI == EPI_MIX) {
                const float bias = p.bs[head * GL + r];
                const float4 u = *(const float4*)cp; const float4 z = *(const float4*)(R + (size_t)r * p.ldr + c);
                v.x = u.x * (v.x + bias) * z.x; v.y = u.y * (v.y + bias) * z.y; v.z = u.z * (v.z + bias) * z.z; v.w = u.w * (v.w + bias) * z.w;
            } else if (EPI == EPI_RES) {
                const float4 x = *(const float4*)(R + (size_t)r * p.ldr + c);
                v.x += x.x; v.y += x.y; v.z += x.z; v.w += x.w;
            }
            *(float4*)cp = v;
        }
    }
}

__global__ __launch_bounds__(256) void k_attn(const float* __restrict__ KV, float* __restrict__ QZ, const float* __restrict__ relb) {
    __shared__ float Ks[64][65];
    __shared__ float Vs[64][65];
    __shared__ float bias_s[640];
    const int c = blockIdx.x, h = blockIdx.y, tid = threadIdx.x, qi = tid >> 2, sub = tid & 3;
    for (int e = tid; e < 640; e += 256) { int rel = e - 63; rel = rel < -256 ? -256 : (rel > 256 ? 256 : rel); bias_s[e] = relb[h * NREL + rel + 256]; }
    float q[64], o[64];
    const float* qp = QZ + (size_t)(c * 64 + qi) * 2048 + h * 64;
#pragma unroll
    for (int d = 0; d < 64; d += 4) { const float4 v = *(const float4*)(qp + d); q[d] = v.x * 0.125f; q[d + 1] = v.y * 0.125f; q[d + 2] = v.z * 0.125f; q[d + 3] = v.w * 0.125f; }
#pragma unroll
    for (int d = 0; d < 64; ++d) o[d] = 0.f;
    float m = -1e30f, l = 0.f;
    for (int jt = 0; jt < 9; ++jt) {
        const int kc = c - 8 + jt;
        if (kc < 0) continue;
        __syncthreads();
        for (int e = tid; e < 64 * 16; e += 256) {
            const int r = e >> 4, d4 = (e & 15) * 4;
            const float4 kv = *(const float4*)(KV + (size_t)(kc * 64 + r) * 2048 + h * 64 + d4);
            const float4 vv = *(const float4*)(KV + (size_t)(kc * 64 + r) * 2048 + 1024 + h * 64 + d4);
            Ks[r][d4] = kv.x; Ks[r][d4 + 1] = kv.y; Ks[r][d4 + 2] = kv.z; Ks[r][d4 + 3] = kv.w;
            Vs[r][d4] = vv.x; Vs[r][d4 + 1] = vv.y; Vs[r][d4 + 2] = vv.z; Vs[r][d4 + 3] = vv.w;
        }
        __syncthreads();
        for (int kk = sub; kk < 64; kk += 4) {
            float s = 0.f;
#pragma unroll
            for (int d = 0; d < 64; ++d) s = fmaf(q[d], Ks[kk][d], s);
            s += bias_s[(c * 64 + qi) - (kc * 64 + kk) + 63];
            const float mn = fmaxf(m, s), al = expf(m - mn), pe = expf(s - mn);
            l = l * al + pe; m = mn;
#pragma unroll
            for (int d = 0; d < 64; ++d) o[d] = fmaf(o[d], al, pe * Vs[kk][d]);
        }
    }
    float ma = fmaxf(m, __shfl_xor(m, 1)); ma = fmaxf(ma, __shfl_xor(ma, 2));
    const float sc = expf(m - ma);
    l *= sc; l += __shfl_xor(l, 1); l += __shfl_xor(l, 2);
    const float inv = 1.f / l;
    float* op = QZ + (size_t)(c * 64 + qi) * 2048 + h * 64;
#pragma unroll
    for (int d = 0; d < 64; ++d) { float v = o[d] * sc; v += __shfl_xor(v, 1); v += __shfl_xor(v, 2); o[d] = v * inv; }
    __syncthreads();
#pragma unroll
    for (int d = 0; d < 16; ++d) { const int dd = sub * 16 + d; float ov = 0.f;
#pragma unroll
        for (int e = 0; e < 64; ++e) if (e == dd) ov = o[e];
        op[dd] = ov * silu_f(op[1024 + dd]); }
}

extern "C" void kernel_launch(void* const* d_in, const int* in_sizes, int n_in, void* d_out, int out_size, void* d_ws, size_t ws_size, hipStream_t stream) {
    const float* x = (const float*)d_in[0]; const float* a_norm_g = (const float*)d_in[1]; const float* a_w_in = (const float*)d_in[2];
    const float* a_ln_g = (const float*)d_in[3]; const float* a_ln_b = (const float*)d_in[4]; const float* a_w_s = (const float*)d_in[5];
    const float* a_b_s = (const float*)d_in[6]; const float* a_w_out = (const float*)d_in[7]; const float* kv_norm_g = (const float*)d_in[8];
    const float* w_kv = (const float*)d_in[9]; const float* b_norm_g = (const float*)d_in[10]; const float* b_w_qz = (const float*)d_in[11];
    const float* b_rel_bias = (const float*)d_in[12]; const float* b_w_out = (const float*)d_in[13]; const float* final_norm_g = (const float*)d_in[14];
    float* out = (float*)d_out;
    char* ws = (char*)d_ws; const size_t MiB = 1u << 20;
    float* XN = (float*)(ws);
    float* UVZ = (float*)(ws + 16 * MiB);
    float* KV = (float*)(ws + 112 * MiB);
    float* QZ = (float*)(ws + 144 * MiB);
    float* WM = (float*)(ws + 176 * MiB);
    k_mask_ws<<<AH * GL * GL / 256, 256, 0, stream>>>(a_w_s, WM);
    for (int b = 0; b < BATCH; ++b) {
        const float* xb = x + (size_t)b * MB * D; float* ob = out + (size_t)b * MB * D;
        k_rmsnorm<<<MB, 256, 0, stream>>>(xb, a_norm_g, XN);
        { GP p{}; p.A = XN; p.lda = D; p.B = a_w_in; p.ldb = NIN; p.C = UVZ; p.ldc = NIN; p.K = D;
          k_sgemm<EPI_ACT1><<<dim3(NIN / 128, MB / 128), 256, 0, stream>>>(p); }
        k_ln_v<<<MB, 256, 0, stream>>>(UVZ, a_ln_g, a_ln_b);
        { GP p{}; p.A = WM; p.lda = GL; p.B = UVZ + AW; p.ldb = NIN; p.C = UVZ; p.ldc = NIN; p.K = GL; p.R = UVZ + 2 * AW; p.ldr = NIN; p.bs = a_b_s;
          k_sgemm<EPI_MIX><<<dim3(AH, MB / GL), 256, 0, stream>>>(p); }
        { GP p{}; p.A = UVZ; p.lda = NIN; p.B = a_w_out; p.ldb = D; p.C = ob; p.ldc = D; p.K = AW; p.R = xb; p.ldr = D;
          k_sgemm<EPI_RES><<<dim3(D / 128, MB / 128), 256, 0, stream>>>(p); }
        k_rmsnorm<<<MB, 256, 0, stream>>>(ob, kv_norm_g, XN);
        { GP p{}; p.A = XN; p.lda = D; p.B = w_kv; p.ldb = 2 * BW; p.C = KV; p.ldc = 2 * BW; p.K = D;
          k_sgemm<EPI_PLAIN><<<dim3(2 * BW / 128, MB / 128), 256, 0, stream>>>(p); }
        k_rmsnorm<<<MB, 256, 0, stream>>>(ob, b_norm_g, XN);
        { GP p{}; p.A = XN; p.lda = D; p.B = b_w_qz; p.ldb = 2 * BW; p.C = QZ; p.ldc = 2 * BW; p.K = D;
          k_sgemm<EPI_PLAIN><<<dim3(2 * BW / 128, MB / 128), 256, 0, stream>>>(p); }
        k_attn<<<dim3(SEQ / CHUNK, BH), 256, 0, stream>>>(KV, QZ, b_rel_bias);
        { GP p{}; p.A = QZ; p.lda = 2 * BW; p.B = b_w_out; p.ldb = D; p.C = ob; p.ldc = D; p.K = BW; p.R = ob; p.ldr = D;
          k_sgemm<EPI_RES><<<dim3(D / 128, MB / 128), 256, 0, stream>>>(p); }
        k_rmsnorm<<<MB, 256, 0, stream>>>(ob, final_norm_g, ob);
    }
}
```

```cpp
#include <hip/hip_runtime.h>
#include <cstdio>
#include <cstdint>
namespace pg8 {
#define PG8_LAS __attribute__((address_space(3)))
typedef unsigned short bf16_t;
typedef short bf16x8 __attribute__((ext_vector_type(8)));
typedef float f32x4 __attribute__((ext_vector_type(4)));
typedef unsigned u32x4 __attribute__((ext_vector_type(4)));
constexpr int BM = 256, BK = 64, HALF = 128, HTB = HALF * BK * 2  , STAGE_BYTES = 8 * HTB, NXCD = 8, WGM = 8;

__host__ __device__ __forceinline__ int lds_byte(int r, int c) { const int st = (r >> 4) * 2 + (c >> 5), rr = r & 15, cc = c & 31, ob = rr * 64 + cc * 2; return st * 1024 + (ob ^ (((ob >> 9) & 1) << 5)); }
__host__ __device__ __forceinline__ void stage_rc(int b, int& R, int& C) { const int st = b / 1024, sb = b % 1024, swz = sb ^ (((sb >> 9) & 1) << 5); R = (st >> 1) * 16 + swz / 64; C = (st & 1) * 32 + (swz % 64) / 2; }
__host__ __device__ __forceinline__ int perm32(int rho) { const int n = rho >> 4, i = rho & 15; return 8 * (i >> 2) + 4 * n + (i & 3); }

struct Unit { int pm, pn; };
struct Gemm { const bf16_t* A; const bf16_t* Bt; int M, N, K; };

struct StaticOrder {
    int nM, nN, nwg, G, c;
    __host__ __device__ void init(int M, int N, int G_, int c_) { nM = M / BM; nN = N / BM; nwg = nM * nN; G = G_; c = c_; }
    __host__ __device__ bool next(int i, Unit& u) const {
        const long L = (long)i * G + c; if (L >= nwg) return false;
        int wgid = (int)L; { const int q = nwg / NXCD, r = nwg % NXCD, xcd = wgid % NXCD, off = wgid / NXCD; wgid = (xcd < r ? xcd * (q + 1) : r * (q + 1) + (xcd - r) * q) + off; }
        const int nig = WGM * nN, gid = wgid / nig, fm = gid * WGM, gsz = (nM - fm) < WGM ? (nM - fm) : WGM;
        u.pm = fm + ((wgid % nig) % gsz); u.pn = (wgid % nig) / gsz; return true;
    }
    __device__ __forceinline__ void a_ready(const Unit&) const {}
    __device__ __forceinline__ void done(const Unit&) const {}
};
__device__ __forceinline__ unsigned cvt_pk_bf16(float lo, float hi) { unsigned r; asm volatile("v_cvt_pk_bf16_f32 %0, %1, %2" : "=v"(r) : "v"(lo), "v"(hi)); return r; }
template <class Epi, class Sched, bool ALIGN_EPI = false, bool SP2 = false>
__device__ __forceinline__ void gemm_phase(PG8_LAS unsigned char* lds, const Gemm g, const Sched& S, const Epi& E) {
    const int tid = threadIdx.x, wid = __builtin_amdgcn_readfirstlane(tid >> 6), lane = tid & 63, wr = wid >> 2, wc = wid & 3, fr = lane & 15, fq = lane >> 4;
    const int K = g.K, nt = K / BK;
    unsigned voffA[2], voffB[2];
#pragma unroll
    for (int i = 0; i < 2; ++i) { int R, C; stage_rc(tid * 16 + i * 8192, R, C); const int Rb = Epi::PERM ? ((R & ~31) + perm32(R & 31)) : R;
        voffA[i] = (unsigned)(R * K + C) * 2u; voffB[i] = (unsigned)(Rb * K + C) * 2u; }
    const size_t kstep = (size_t)(BK * 2);
    const size_t hstep = (size_t)HALF * K * 2;
    const size_t tstep = 2 * hstep;
    const unsigned ldsw = (unsigned)wid * 1024u;
    const int aoff = lds_byte(wr * 64 + fr, fq * 8), boff = lds_byte(wc * 32 + fr, fq * 8);
#define PG8_SA(b, h) (((b) * 2 + (h)) * HTB)
#define PG8_SB(b, h) ((4 + (b) * 2 + (h)) * HTB)
#define PG8_STAGE(bufoff, gbase, voff) do { _Pragma("unroll") for (int _i = 0; _i < 2; ++_i) \
        __builtin_amdgcn_global_load_lds((const unsigned*)((const char*)(gbase) + (voff)[_i]), (PG8_LAS unsigned*)(lds + (bufoff) + ldsw + _i * 8192), 16, 0, 0); } while (0)
#define PG8_LDA(dst, b, h) do { _Pragma("unroll") for (int m = 0; m < 4; ++m) _Pragma("unroll") for (int k = 0; k < 2; ++k) dst[m][k] = *(const PG8_LAS bf16x8*)(lds + PG8_SA(b, h) + aoff + m * 2048 + k * 1024); } while (0)
#define PG8_LDB(dst, b, h) do { _Pragma("unroll") for (int n = 0; n < 2; ++n) _Pragma("unroll") for (int k = 0; k < 2; ++k) dst[n][k] = *(const PG8_LAS bf16x8*)(lds + PG8_SB(b, h) + boff + n * 2048 + k * 1024); } while (0)
#define PG8_MMA(ai, bj, At, Bt) do { __builtin_amdgcn_s_setprio(1); _Pragma("unroll") for (int m = 0; m < 4; ++m) _Pragma("unroll") for (int n = 0; n < 2; ++n) _Pragma("unroll") for (int k = 0; k < 2; ++k) \
        acc[ai][bj][m][n] = __builtin_amdgcn_mfma_f32_16x16x32_bf16(Bt[n][k], At[m][k], acc[ai][bj][m][n], 0, 0, 0); __builtin_amdgcn_s_setprio(0); } while (0)
#define PG8_WAIT_V(n) asm volatile("s_waitcnt vmcnt(" #n ")" ::: "memory")
#define PG8_WAIT_L(n) asm volatile("s_waitcnt lgkmcnt(" #n ")" ::: "memory")
#define PG8_BAR __builtin_amdgcn_s_barrier()
#define PG8_SCHED __builtin_amdgcn_sched_barrier(0)
    Unit cur, nxt; int ui = 0;
    if (!S.next(0, cur)) return;
    f32x4 acc[2][2][4][2];
#pragma unroll
    for (int a = 0; a < 2; ++a)
#pragma unroll
        for (int b = 0; b < 2; ++b)
#pragma unroll
            for (int m = 0; m < 4; ++m)
#pragma unroll
                for (int n = 0; n < 2; ++n) acc[a][b][m][n] = (f32x4){0.f, 0.f, 0.f, 0.f};
    bf16x8 At[4][2], B0[2][2], B1[2][2];
    const char* cA = (const char*)g.A + (size_t)cur.pm * tstep; const char* cB = (const char*)g.Bt + (size_t)cur.pn * tstep;
    S.a_ready(cur);
    if constexpr (SP2) {
        PG8_STAGE(PG8_SB(0, 0), cB, voffB); PG8_STAGE(PG8_SB(0, 1), cB + hstep, voffB); PG8_STAGE(PG8_SA(0, 0), cA, voffA); PG8_STAGE(PG8_SA(0, 1), cA + hstep, voffA);
        if (wr == 1) PG8_BAR;
        PG8_WAIT_V(2); PG8_BAR;
        PG8_STAGE(PG8_SB(1, 0), cB + kstep, voffB); PG8_STAGE(PG8_SA(1, 0), cA + kstep, voffA); PG8_STAGE(PG8_SB(1, 1), cB + hstep + kstep, voffB);
        PG8_WAIT_V(6); PG8_BAR;
    } else {
        PG8_STAGE(PG8_SB(0, 0), cB, voffB); PG8_STAGE(PG8_SA(0, 0), cA, voffA); PG8_STAGE(PG8_SB(0, 1), cB + hstep, voffB); PG8_STAGE(PG8_SA(0, 1), cA + hstep, voffA);
        if (wr == 1) PG8_BAR;
        PG8_WAIT_V(4); PG8_BAR;
        PG8_STAGE(PG8_SB(1, 0), cB + kstep, voffB); PG8_STAGE(PG8_SA(1, 0), cA + kstep, voffA); PG8_STAGE(PG8_SB(1, 1), cB + hstep + kstep, voffB);
        PG8_WAIT_V(6); PG8_BAR;
    }
    for (;;) {
        const bool has_next = S.next(ui + 1, nxt);
        const char* nA = has_next ? (const char*)g.A + (size_t)nxt.pm * tstep : cA; const char* nB = has_next ? (const char*)g.Bt + (size_t)nxt.pn * tstep : cB;
        for (int t = 0; t < nt; t += 2) {
            const bool last = (t == nt - 2);
            const char* a1 = cA + (size_t)(t + 1) * kstep;
            const char* a2 = last ? nA : cA + (size_t)(t + 2) * kstep; const char* b2 = last ? nB : cB + (size_t)(t + 2) * kstep;
            const char* a3 = a2 + kstep; const char* b3 = b2 + kstep;
            if (last && has_next) S.a_ready(nxt);
            if constexpr (SP2) {
            PG8_LDB(B0, 0, 0); PG8_LDB(B1, 0, 1); PG8_SCHED; PG8_LDA(At, 0, 0); PG8_STAGE(PG8_SA(1, 1), a1 + hstep, voffA);
            PG8_WAIT_V(8); PG8_WAIT_L(0); PG8_BAR; PG8_MMA(0, 0, At, B0); PG8_MMA(0, 1, At, B1); PG8_BAR; PG8_SCHED;
            PG8_LDA(At, 0, 1); PG8_STAGE(PG8_SB(0, 0), b2, voffB); PG8_STAGE(PG8_SB(0, 1), b2 + hstep, voffB); PG8_STAGE(PG8_SA(0, 0), a2, voffA);
            PG8_WAIT_V(8); PG8_WAIT_L(0); PG8_BAR; PG8_MMA(1, 0, At, B0); PG8_MMA(1, 1, At, B1); PG8_BAR; PG8_SCHED;
            PG8_LDB(B0, 1, 0); PG8_LDB(B1, 1, 1); PG8_SCHED; PG8_LDA(At, 1, 0); PG8_STAGE(PG8_SA(0, 1), a2 + hstep, voffA);
            PG8_WAIT_V(8); PG8_WAIT_L(0); PG8_BAR; PG8_MMA(0, 0, At, B0); PG8_MMA(0, 1, At, B1); PG8_BAR; PG8_SCHED;
            PG8_LDA(At, 1, 1); PG8_STAGE(PG8_SB(1, 0), b3, voffB); PG8_STAGE(PG8_SB(1, 1), b3 + hstep, voffB); PG8_STAGE(PG8_SA(1, 0), a3, voffA);
            PG8_WAIT_V(8); PG8_WAIT_L(0); PG8_BAR; PG8_MMA(1, 0, At, B0); PG8_MMA(1, 1, At, B1); PG8_BAR; PG8_SCHED;
            } else {
            PG8_LDB(B0, 0, 0); PG8_SCHED; PG8_LDA(At, 0, 0); PG8_STAGE(PG8_SA(1, 1), a1 + hstep, voffA);
            PG8_WAIT_L(8); PG8_BAR; PG8_WAIT_L(0); PG8_MMA(0, 0, At, B0); PG8_BAR; PG8_SCHED;
            PG8_LDB(B1, 0, 1); PG8_STAGE(PG8_SB(0, 0), b2, voffB);
            PG8_BAR; PG8_WAIT_L(0); PG8_MMA(0, 1, At, B1); PG8_BAR;
            PG8_LDA(At, 0, 1); PG8_STAGE(PG8_SA(0, 0), a2, voffA);
            PG8_BAR; PG8_WAIT_L(0); PG8_MMA(1, 0, At, B0); PG8_BAR; PG8_SCHED;
            PG8_STAGE(PG8_SB(0, 1), b2 + hstep, voffB);
            PG8_WAIT_V(6); PG8_BAR; PG8_MMA(1, 1, At, B1); PG8_BAR;
            PG8_LDB(B0, 1, 0); PG8_SCHED; PG8_LDA(At, 1, 0); PG8_STAGE(PG8_SA(0, 1), a2 + hstep, voffA);
            PG8_WAIT_L(8); PG8_BAR; PG8_WAIT_L(0); PG8_MMA(0, 0, At, B0); PG8_BAR; PG8_SCHED;
            PG8_LDB(B1, 1, 1); PG8_STAGE(PG8_SB(1, 0), b3, voffB);
            PG8_BAR; PG8_WAIT_L(0); PG8_MMA(0, 1, At, B1); PG8_BAR;
            PG8_LDA(At, 1, 1); PG8_STAGE(PG8_SA(1, 0), a3, voffA);
            PG8_BAR; PG8_WAIT_L(0); PG8_MMA(1, 0, At, B0); PG8_BAR; PG8_SCHED;
            PG8_STAGE(PG8_SB(1, 1), b3 + hstep, voffB);
            PG8_WAIT_V(6); PG8_BAR; PG8_MMA(1, 1, At, B1); PG8_BAR;
            }
        }
        if constexpr (ALIGN_EPI) { if (wr == 0) PG8_BAR; }
        if constexpr (!Epi::AFTER_DRAIN) { E(acc, cur, wr, wc, fr, fq); S.done(cur); }
        if (!has_next) break;
#pragma unroll
        for (int a = 0; a < 2; ++a)
#pragma unroll
            for (int b = 0; b < 2; ++b)
#pragma unroll
                for (int m = 0; m < 4; ++m)
#pragma unroll
                    for (int n = 0; n < 2; ++n) acc[a][b][m][n] = (f32x4){0.f, 0.f, 0.f, 0.f};
        cur = nxt; cA = nA; cB = nB; ++ui;
        if constexpr (ALIGN_EPI) { if (wr == 1) PG8_BAR; }
    }
    PG8_WAIT_V(0);
    if constexpr (!ALIGN_EPI) { if (wr == 0) PG8_BAR; }
    PG8_BAR;
    if constexpr (Epi::AFTER_DRAIN) { E.fused(acc, cur, wr, wc, fr, fq, lds, wid, lane); S.done(cur); }
#undef PG8_SA
#undef PG8_SB
#undef PG8_STAGE
#undef PG8_LDA
#undef PG8_LDB
#undef PG8_MMA
#undef PG8_WAIT_V
#undef PG8_WAIT_L
#undef PG8_BAR
#undef PG8_SCHED
}
}
namespace pg8 {
typedef float f32x2e __attribute__((ext_vector_type(2)));
__device__ __forceinline__ float fast_gelu(float x) {
    const float t = x * __builtin_fmaf(x * x, 0.10294324f, 2.30220820f);
    return x * __builtin_amdgcn_rcpf(1.f + __builtin_amdgcn_exp2f(-t));
}
__device__ __forceinline__ float fast_silu(float x) { return x * __builtin_amdgcn_rcpf(1.f + __builtin_amdgcn_exp2f(-1.4426950409f * x)); }

struct EpiAct1 {
    static constexpr bool PERM = true, AFTER_DRAIN = false;
    bf16_t* U; bf16_t* GV; bf16_t* SZ; f32x2e* VST;
    template <int KIND> __device__ __forceinline__ void body(const f32x4 (&acc)[2][2][4][2], const Unit& u, int wr, int wc, int fr, int fq) const {
        const int pt = u.pn & 7;
        bf16_t* base = KIND == 0 ? U : (KIND == 1 ? GV : SZ);
        const int row0 = u.pm * BM + wr * 64 + fr, col0 = pt * BM + wc * 32 + 8 * fq;
#pragma unroll
        for (int ai = 0; ai < 2; ++ai)
#pragma unroll
            for (int m = 0; m < 4; ++m) {
                const int row = row0 + ai * HALF + m * 16; bf16_t* rowp = base + (size_t)row * 2048 + col0;
                float s = 0.f, q = 0.f;
#pragma unroll
                for (int bj = 0; bj < 2; ++bj) {
                    f32x4 v0 = acc[ai][bj][m][0], v1 = acc[ai][bj][m][1];
#pragma unroll
                    for (int j = 0; j < 4; ++j) { v0[j] = KIND == 2 ? fast_silu(v0[j]) : fast_gelu(v0[j]); v1[j] = KIND == 2 ? fast_silu(v1[j]) : fast_gelu(v1[j]); }
                    if (KIND == 1) {
                        s += ((v0[0] + v0[1]) + (v0[2] + v0[3])) + ((v1[0] + v1[1]) + (v1[2] + v1[3]));
                        q += ((v0[0] * v0[0] + v0[1] * v0[1]) + (v0[2] * v0[2] + v0[3] * v0[3])) + ((v1[0] * v1[0] + v1[1] * v1[1]) + (v1[2] * v1[2] + v1[3] * v1[3]));
                    }
                    u32x4 w; w.x = cvt_pk_bf16(v0[0], v0[1]); w.y = cvt_pk_bf16(v0[2], v0[3]); w.z = cvt_pk_bf16(v1[0], v1[1]); w.w = cvt_pk_bf16(v1[2], v1[3]);
                    *(u32x4*)(rowp + bj * HALF) = w;
                }
                if (KIND == 1) {
                    s += __shfl_xor(s, 16); s += __shfl_xor(s, 32); q += __shfl_xor(q, 16); q += __shfl_xor(q, 32);
                    if (fq == 0) VST[(size_t)row * 32 + pt * 4 + wc] = (f32x2e){s, q};
                }
            }
    }
    __device__ __forceinline__ void operator()(const f32x4 (&acc)[2][2][4][2], const Unit& u, int wr, int wc, int fr, int fq) const {
        const int kind = u.pn >> 3;
        if (kind == 0) body<0>(acc, u, wr, wc, fr, fq); else if (kind == 1) body<1>(acc, u, wr, wc, fr, fq); else body<2>(acc, u, wr, wc, fr, fq);
    }
};
template <bool WRITE_BF16> struct EpiRes {
    static constexpr bool PERM = false, AFTER_DRAIN = false;
    const float* res; float* out; bf16_t* XB; float* SS;
    __device__ __forceinline__ void operator()(const f32x4 (&acc)[2][2][4][2], const Unit& u, int wr, int wc, int fr, int fq) const {
        const int row0 = u.pm * BM + wr * 64 + fr, col0 = u.pn * BM + wc * 32 + 4 * fq;
#pragma unroll
        for (int ai = 0; ai < 2; ++ai)
#pragma unroll
            for (int m = 0; m < 4; ++m) {
                const int row = row0 + ai * HALF + m * 16; const size_t off = (size_t)row * 1024 + col0; float ss = 0.f;
#pragma unroll
                for (int bj = 0; bj < 2; ++bj)
#pragma unroll
                    for (int n = 0; n < 2; ++n) {
                        const f32x4 r = *(const f32x4*)(res + off + bj * HALF + n * 16); const f32x4 v = r + acc[ai][bj][m][n];
                        *(f32x4*)(out + off + bj * HALF + n * 16) = v;
                        ss += (v[0] * v[0] + v[1] * v[1]) + (v[2] * v[2] + v[3] * v[3]);
                        if (WRITE_BF16) { f32x2e w; unsigned w0 = cvt_pk_bf16(v[0], v[1]), w1 = cvt_pk_bf16(v[2], v[3]); typedef unsigned u32x2e __attribute__((ext_vector_type(2))); *(u32x2e*)(XB + off + bj * HALF + n * 16) = (u32x2e){w0, w1}; (void)w; }
                    }
                ss += __shfl_xor(ss, 16); ss += __shfl_xor(ss, 32);
                if (fq == 0) SS[(size_t)row * 16 + u.pn * 4 + wc] = ss;
            }
    }
};
struct EpiKVQZ {
    static constexpr bool PERM = true, AFTER_DRAIN = false;
    bf16_t* KVQZ; const float* SS; float qscale;
    __device__ __forceinline__ void operator()(const f32x4 (&acc)[2][2][4][2], const Unit& u, int wr, int wc, int fr, int fq) const {
        const int kind = u.pn >> 2, pt = u.pn & 3;
        bf16_t* base = KVQZ + (size_t)kind * ((size_t)16384 * 1024);
        const int row0 = u.pm * BM + wr * 64 + fr, col0 = pt * BM + wc * 32 + 8 * fq;
#pragma unroll
        for (int ai = 0; ai < 2; ++ai)
#pragma unroll
            for (int m = 0; m < 4; ++m) {
                const int row = row0 + ai * HALF + m * 16; bf16_t* rowp = base + (size_t)row * 1024 + col0;
                const f32x4* sp = (const f32x4*)(SS + (size_t)row * 16); const f32x4 s0 = sp[0], s1 = sp[1], s2 = sp[2], s3 = sp[3];
                const float tot = (((s0[0] + s0[1]) + (s0[2] + s0[3])) + ((s1[0] + s1[1]) + (s1[2] + s1[3]))) + (((s2[0] + s2[1]) + (s2[2] + s2[3])) + ((s3[0] + s3[1]) + (s3[2] + s3[3])));
                float rs = __builtin_amdgcn_rsqf(tot * (1.f / 1024.f) + 1e-6f); if (kind == 2) rs *= qscale;
#pragma unroll
                for (int bj = 0; bj < 2; ++bj) {
                    f32x4 v0 = acc[ai][bj][m][0] * rs, v1 = acc[ai][bj][m][1] * rs;
                    if (kind == 3) {
#pragma unroll
                        for (int j = 0; j < 4; ++j) { v0[j] = fast_silu(v0[j]); v1[j] = fast_silu(v1[j]); }
                    }
                    u32x4 w; w.x = cvt_pk_bf16(v0[0], v0[1]); w.y = cvt_pk_bf16(v0[2], v0[3]); w.z = cvt_pk_bf16(v1[0], v1[1]); w.w = cvt_pk_bf16(v1[2], v1[3]);
                    *(u32x4*)(rowp + bj * HALF) = w;
                }
            }
    }
};
}
#ifndef PG8_SP2
#define PG8_SP2 true
#endif
#ifndef PG8_ALIGN
#define PG8_ALIGN true
#endif
constexpr int NWAVES = 8;
constexpr int M = 16384, D = 1024, SEQ = 4096, AW = 2048, NIN = 3 * AW;
constexpr int GL = 128, AH = 16, HC = 128;
constexpr int BH = 16, HD = 64, NREL = 513;
constexpr float NORM_EPS = 1e-6f;
constexpr float QSCALE = 0.125f * 1.4426950408889634f;
constexpr float LOG2E = 1.4426950408889634f;
constexpr size_t MiB = 1u << 20;
constexpr size_t WS_CTL = 0, CTL_ZERO_BYTES = 1 * MiB;
constexpr size_t WS_WIN = 1 * MiB, WS_WAOUT = 13 * MiB, WS_WKVQZ = 17 * MiB, WS_WBOUT = 25 * MiB, WS_WM = 27 * MiB;
constexpr size_t WS_VST = 28 * MiB;
constexpr size_t WS_SS1 = 28 * MiB, WS_SS2 = 29 * MiB;
constexpr size_t WS_XN = 32 * MiB;
constexpr size_t WS_U = 64 * MiB, WS_GV = 128 * MiB, WS_SZ = 192 * MiB;
constexpr size_t WS_K = 64 * MiB, WS_V = 96 * MiB, WS_Q = 128 * MiB, WS_ZB = 160 * MiB;
constexpr size_t WS_END = 256 * MiB;
constexpr int CW_BAR = 4096;
constexpr int RING_OFF = 0, RING_BYTES = 131072;
constexpr int LDSCTL_OFF = RING_BYTES, MISC_OFF = LDSCTL_OFF + 320;
constexpr int LDS_BYTES = 147456;

#define GAS __attribute__((address_space(1)))
#define LAS __attribute__((address_space(3)))
typedef unsigned short bf16;
typedef unsigned v4u __attribute__((ext_vector_type(4)));
typedef unsigned v2u __attribute__((ext_vector_type(2)));
typedef float f32x4 __attribute__((ext_vector_type(4)));
typedef float f32x2 __attribute__((ext_vector_type(2)));
typedef short bf16x8 __attribute__((ext_vector_type(8)));
typedef GAS unsigned gu32;
typedef GAS unsigned long long gu64;
#define RLX_AGENT __ATOMIC_RELAXED, __HIP_MEMORY_SCOPE_AGENT
#define LDS_WAIT() asm volatile("s_waitcnt lgkmcnt(0)" ::: "memory")
#define VM_WAIT() asm volatile("s_waitcnt vmcnt(0)" ::: "memory")
__device__ __forceinline__ unsigned f2bf(float f) { unsigned u = __builtin_bit_cast(unsigned, f); return (u + 0x7fffu + ((u >> 16) & 1u)) >> 16; }
__device__ __forceinline__ unsigned pk2(float lo, float hi) { return f2bf(lo) | (f2bf(hi) << 16); }
__device__ __forceinline__ float bf2f(unsigned short b) { return __builtin_bit_cast(float, (unsigned)b << 16); }
__device__ __forceinline__ float bflo(unsigned w) { return __builtin_bit_cast(float, w << 16); }
__device__ __forceinline__ float bfhi(unsigned w) { return __builtin_bit_cast(float, w & 0xffff0000u); }
#define XB_TMO      128
#define XB_XCNT(j)  (256  + 64 * (j))
#define XB_XSUB(j)  (1280 + 64 * (j))
#define XB_XGEN(j)  (2304 + 64 * (j))
#define XB_TOP      3328
#define XB_TOPGEN   3392
#define XCD_BAR_WORDS 3456
#define XB_SPIN_CAP (1u << 18)

__device__ __forceinline__ unsigned xb_ld(unsigned* p)              { return __hip_atomic_load(p, __ATOMIC_RELAXED, __HIP_MEMORY_SCOPE_AGENT); }
__device__ __forceinline__ unsigned xb_add(unsigned* p, unsigned v) { return __hip_atomic_fetch_add(p, v, __ATOMIC_RELAXED, __HIP_MEMORY_SCOPE_AGENT); }
__device__ __forceinline__ unsigned xb_xcc_id() { return (unsigned)__builtin_amdgcn_s_getreg((3 << 11) | 20) & 0xFu; }
#define XB_SPIN(cond, bar) do { unsigned _sp = 0; while (cond) { __builtin_amdgcn_s_sleep(1); \
    if ((++_sp & 255u) == 0u) { if (xb_ld(&(bar)[XB_TMO])) break; if (_sp > XB_SPIN_CAP) { atomicAdd(&(bar)[XB_TMO], 1u); break; } } } } while (0)

struct XcdBarrier {
    unsigned* bar; unsigned x;
    volatile LAS unsigned* st;
};

__device__ __forceinline__ XcdBarrier xcd_barrier_post(unsigned* bar, volatile LAS unsigned* st) {
    XcdBarrier b; b.bar = bar; b.x = xb_xcc_id(); b.st = st;
    if (threadIdx.x == 0) (void)xb_add(&bar[XB_XCNT(b.x)], 1u);
    return b;
}
__device__ __forceinline__ void xcd_barrier_complete(unsigned* bar, unsigned x, unsigned& nloc, unsigned& nx) {
    const unsigned G = gridDim.x * gridDim.y * gridDim.z;
    unsigned sum, cnt, mine, sp = 0u;
    for (;;) {
        sum = 0u; cnt = 0u; mine = 0u;
#pragma unroll
        for (unsigned j = 0; j < 16; ++j) { const unsigned c = xb_ld(&bar[XB_XCNT(j)]); sum += c; cnt += (c > 0u) ? 1u : 0u; mine = (j == x) ? c : mine; }
        if (sum == G) break;
        __builtin_amdgcn_s_sleep(1);
        if ((++sp & 255u) == 0u) { if (xb_ld(&bar[XB_TMO])) break; if (sp > XB_SPIN_CAP) { atomicAdd(&bar[XB_TMO], 1u); break; } }
    }
    nloc = mine > 0u ? mine : 1u; nx = cnt > 0u ? cnt : 1u;
}

__device__ __forceinline__ void xcd_barrier(const XcdBarrier& b) {
    asm volatile("s_waitcnt vmcnt(0)" ::: "memory");
    __syncthreads();
    if (threadIdx.x == 0) {
        unsigned* bar = b.bar;
        __builtin_amdgcn_s_waitcnt(0);
        unsigned nloc = b.st[0], nx = b.st[1];
        if (nloc == 0u) { xcd_barrier_complete(bar, b.x, nloc, nx); b.st[0] = nloc; b.st[1] = nx; }
        const unsigned old = xb_add(&bar[XB_XSUB(b.x)], 1u);
        const unsigned gen = old / nloc;
        if (old + 1u == (gen + 1u) * nloc) {
            __builtin_amdgcn_fence(__ATOMIC_RELEASE, "agent");
            asm volatile("s_waitcnt vmcnt(0)" ::: "memory");
            const unsigned og = xb_add(&bar[XB_TOP], 1u);
            const unsigned tg = og / nx;
            if (og + 1u == (tg + 1u) * nx) xb_add(&bar[XB_TOPGEN], 1u);
            else XB_SPIN(xb_ld(&bar[XB_TOPGEN]) == tg, bar);
            __builtin_amdgcn_fence(__ATOMIC_ACQUIRE, "agent");
            xb_add(&bar[XB_XGEN(b.x)], 1u);
            asm volatile("s_waitcnt vmcnt(0)" ::: "memory");
        } else {
            XB_SPIN(xb_ld(&bar[XB_XGEN(b.x)]) == gen, bar);
            __builtin_amdgcn_fence(__ATOMIC_ACQUIRE, "agent");
            asm volatile("s_waitcnt vmcnt(0)" ::: "memory");
        }
    }
    __syncthreads();
}
struct Ctx {
    LAS unsigned char* lds; int tid, lane, wave, vcu, G;
};
__device__ __forceinline__ float wave_sum(float v) {
#pragma unroll
    for (int o = 1; o < 64; o <<= 1) v += __shfl_xor(v, o);
    return v;
}
__device__ __forceinline__ void p0_transpose_item(const float* W, int K, int N, bf16* WT, int row_off, const float* gain, LAS float* scr, int item, int lane) {
    const int nblk = N / 32, kb = item / nblk, nb = item % nblk, k0 = 64 * kb, n0 = 32 * nb;
#pragma unroll 8
    for (int i = 0; i < 32; ++i) { const int kk = 2 * i + (lane >> 5); float w = W[(size_t)(k0 + kk) * N + n0 + (lane & 31)]; if (gain) w *= gain[k0 + kk]; scr[kk * 33 + (lane & 31)] = w; }
    LDS_WAIT(); asm volatile("" ::: "memory");
    const int c = lane & 7;
#pragma unroll
    for (int j = 0; j < 4; ++j) { const int n = (lane >> 3) + 8 * j; const LAS float* s = scr + (8 * c) * 33 + n;
        v4u o; o.x = pk2(s[0 * 33], s[1 * 33]); o.y = pk2(s[2 * 33], s[3 * 33]); o.z = pk2(s[4 * 33], s[5 * 33]); o.w = pk2(s[6 * 33], s[7 * 33]);
        *(GAS v4u*)(WT + (size_t)(row_off + n0 + n) * K + k0 + 8 * c) = o; }
    LDS_WAIT(); asm volatile("" ::: "memory");
}
__device__ __forceinline__ void rms_row_to_bf16(int lane, const float* xrow, const float* g, bf16* orow) {
    const GAS f32x4* xr = (const GAS f32x4*)xrow + lane; const GAS f32x4* gr = (const GAS f32x4*)g + lane;
    f32x4 v[4]; float s = 0.f;
#pragma unroll
    for (int j = 0; j < 4; ++j) { v[j] = xr[64 * j]; s += (v[j].x * v[j].x + v[j].y * v[j].y) + (v[j].z * v[j].z + v[j].w * v[j].w); }
    const float rstd = 1.f / sqrtf(wave_sum(s) * (1.f / D) + NORM_EPS);
    GAS unsigned long long* o8 = (GAS unsigned long long*)orow + lane;
#pragma unroll
    for (int j = 0; j < 4; ++j) { const f32x4 gg = gr[64 * j];
        o8[64 * j] = (unsigned long long)pk2(v[j].x * rstd * gg.x, v[j].y * rstd * gg.y) | ((unsigned long long)pk2(v[j].z * rstd * gg.z, v[j].w * rstd * gg.w) << 32); }
}
struct P0Args { const float *x, *a_norm_g, *a_w_in, *a_w_s, *a_w_out, *kv_norm_g, *w_kv, *b_norm_g, *b_w_qz, *b_w_out; bf16 *WIN, *WAOUT, *WKVQZ, *WBOUT, *WM, *XN; };
__device__ __forceinline__ void p0_prologue(const Ctx& F, const P0Args& a) {
    LAS float* scr = (LAS float*)(F.lds + RING_OFF + F.wave * 16384);
    const int gw = F.vcu * NWAVES + F.wave, NGW = F.G * NWAVES;
    constexpr int I_IN = (D / 64) * (NIN / 32), I_AO = (AW / 64) * (D / 32), I_KV = (D / 64) * (2048 / 32), I_QZ = I_KV, I_BO = (D / 64) * (D / 32);
    constexpr int NITEMS = I_IN + I_AO + I_KV + I_QZ + I_BO;
    for (int it = gw; it < NITEMS; it += NGW) {
        int r = it;
        if (r < I_IN) { p0_transpose_item(a.a_w_in, D, NIN, a.WIN, 0, nullptr, scr, r, F.lane); continue; } r -= I_IN;
        if (r < I_AO) { p0_transpose_item(a.a_w_out, AW, D, a.WAOUT, 0, nullptr, scr, r, F.lane); continue; } r -= I_AO;
        if (r < I_KV) { p0_transpose_item(a.w_kv, D, 2048, a.WKVQZ, 0, a.kv_norm_g, scr, r, F.lane); continue; } r -= I_KV;
        if (r < I_QZ) { p0_transpose_item(a.b_w_qz, D, 2048, a.WKVQZ, 2048, a.b_norm_g, scr, r, F.lane); continue; } r -= I_QZ;
        p0_transpose_item(a.b_w_out, D, D, a.WBOUT, 0, nullptr, scr, r, F.lane);
    }
    for (int i = (F.vcu * NWAVES * 64 + F.tid); i < AH * GL * GL / 2; i += F.G * NWAVES * 64) {
        const int e = 2 * i, s = e & 127, t = (e >> 7) & 127; const f32x2 w = *(const GAS f32x2*)(a.a_w_s + e);
        const bool ok = (t >> 6) >= (s >> 6);
        *(GAS unsigned*)(a.WM + e) = ok ? pk2(w.x, w.y) : 0u;
    }
    for (int m = gw; m < M; m += NGW) rms_row_to_bf16(F.lane, a.x + (size_t)m * D, a.a_norm_g, a.XN + (size_t)m * D);
}
__device__ __forceinline__ void p7_final(const Ctx& F, float* out, const float* SS2, const float* g) {
    const int gw = F.vcu * NWAVES + F.wave, NGW = F.G * NWAVES;
    for (int m = gw; m < M; m += NGW) {
        float s = SS2[(size_t)m * 16 + (F.lane & 15)];
        s += __shfl_xor(s, 1); s += __shfl_xor(s, 2); s += __shfl_xor(s, 4); s += __shfl_xor(s, 8);
        const float rstd = 1.f / sqrtf(s * (1.f / D) + NORM_EPS);
        GAS f32x4* xr = (GAS f32x4*)(out + (size_t)m * D) + F.lane; const GAS f32x4* gr = (const GAS f32x4*)g + F.lane;
#pragma unroll
        for (int j = 0; j < 4; ++j) { const f32x4 v = xr[64 * j], gg = gr[64 * j]; xr[64 * j] = v * rstd * gg; }
    }
}
__global__ __launch_bounds__(512) void k_mix_simple(const bf16* GV, bf16* UY, const bf16* SZ, const f32x2* VST, const bf16* WM, const float* ln_g, const float* ln_b, const float* b_s) {
    extern __shared__ __attribute__((aligned(16))) unsigned char lds_raw[];
    float* vn = (float*)lds_raw; float* w = vn + 128 * 129; float* mu = w + 128 * 129; float* rs = mu + 128;
    const int head = blockIdx.x, grp = blockIdx.y, tid = threadIdx.x;
    if (tid < 128) { const size_t row = (size_t)grp * 128 + tid; float s = 0.f, q = 0.f;
        for (int j = 0; j < 32; ++j) { const f32x2 a = VST[row * 32 + j]; s += a.x; q += a.y; }
        const float m = s * (1.f / AW), var = q * (1.f / AW) - m * m; mu[tid] = m; rs[tid] = 1.f / sqrtf(var + NORM_EPS); }
    __syncthreads();
    for (int e = tid; e < 128 * 128; e += 512) { const int s = e >> 7, c = e & 127;
        const float g = bf2f(GV[((size_t)grp * 128 + s) * AW + head * 128 + c]);
        const float v = (g - mu[s]) * rs[s] * ln_g[head * 128 + c] + ln_b[head * 128 + c];
        vn[s * 129 + c] = bf2f((unsigned short)f2bf(v)); w[s * 129 + c] = bf2f(WM[(size_t)head * 16384 + e]); }
    __syncthreads();
    const int t = tid >> 2, cb = (tid & 3) * 32; float acc[32];
#pragma unroll
    for (int j = 0; j < 32; ++j) acc[j] = 0.f;
    for (int s = 0; s < 128; ++s) { const float wv = w[t * 129 + s];
#pragma unroll
        for (int j = 0; j < 32; ++j) acc[j] = fmaf(wv, vn[s * 129 + cb + j], acc[j]); }
    const float bias = b_s[head * 128 + t];
#pragma unroll
    for (int j = 0; j < 32; ++j) { const size_t idx = ((size_t)grp * 128 + t) * AW + head * 128 + cb + j;
        UY[idx] = (unsigned short)f2bf(bf2f(UY[idx]) * (acc[j] + bias) * bf2f(SZ[idx])); }
}
__global__ __launch_bounds__(256) void k_attn_simple(const bf16* Kb, const bf16* Vb, bf16* QO, const bf16* ZB, const float* relb) {
    __shared__ float Ks[64][65];
    __shared__ float Vs[64][65];
    __shared__ float bias_s[640];
    const int c = blockIdx.x, h = blockIdx.y, b = blockIdx.z, tid = threadIdx.x, qi = tid >> 2, sub = tid & 3;
    const size_t rb = (size_t)b * SEQ;
    for (int e = tid; e < 640; e += 256) { int rel = e - 63; rel = rel < -256 ? -256 : (rel > 256 ? 256 : rel); bias_s[e] = relb[h * NREL + rel + 256] * LOG2E; }
    float q[64], o[64];
    const bf16* qp = QO + (rb + c * 64 + qi) * D + h * 64;
#pragma unroll
    for (int d = 0; d < 64; ++d) { q[d] = bf2f(qp[d]); o[d] = 0.f; }
    float m = -1e30f, l = 0.f;
    for (int jt = 0; jt < 9; ++jt) {
        const int kc = c - 8 + jt; if (kc < 0) continue;
        __syncthreads();
        for (int e = tid; e < 64 * 64; e += 256) { const int r = e >> 6, d = e & 63;
            Ks[r][d] = bf2f(Kb[(rb + kc * 64 + r) * D + h * 64 + d]); Vs[r][d] = bf2f(Vb[(rb + kc * 64 + r) * D + h * 64 + d]); }
        __syncthreads();
        for (int kk = sub; kk < 64; kk += 4) {
            float s = 0.f;
#pragma unroll
            for (int d = 0; d < 64; ++d) s = fmaf(q[d], Ks[kk][d], s);
            s += bias_s[(c * 64 + qi) - (kc * 64 + kk) + 63];
            const float mn = fmaxf(m, s), al = exp2f(m - mn), pe = exp2f(s - mn);
            l = l * al + pe; m = mn;
#pragma unroll
            for (int d = 0; d < 64; ++d) o[d] = fmaf(o[d], al, pe * Vs[kk][d]);
        }
    }
    float ma = fmaxf(m, __shfl_xor(m, 1)); ma = fmaxf(ma, __shfl_xor(ma, 2));
    const float sc = exp2f(m - ma);
    l *= sc; l += __shfl_xor(l, 1); l += __shfl_xor(l, 2);
    const float inv = 1.f / l;
#pragma unroll
    for (int d = 0; d < 64; ++d) { float v = o[d] * sc; v += __shfl_xor(v, 1); v += __shfl_xor(v, 2); o[d] = v * inv; }
    bf16* op = QO + (rb + c * 64 + qi) * D + h * 64; const bf16* zp = ZB + (rb + c * 64 + qi) * D + h * 64;
#pragma unroll
    for (int d = 0; d < 16; ++d) { const int dd = sub * 16 + d; float ov = 0.f;
#pragma unroll
        for (int e = 0; e < 64; ++e) if (e == dd) ov = o[e];
        op[dd] = (unsigned short)f2bf(ov * bf2f(zp[dd])); }
}
enum { PH_PRO = 0, PH_G1 = 1, PH_MIX = 2, PH_G2 = 3, PH_G3 = 4, PH_ATT = 5, PH_G4 = 6, PH_FIN = 7, PH_N = 8 };
struct Args { const float* in[15]; float* out; unsigned char* ws; int ph_lo, ph_hi; };
__global__ void __launch_bounds__(NWAVES * 64, 2) fwd(Args args) {
    extern __shared__ __attribute__((aligned(16))) unsigned char lds[];
    Ctx F;
    F.lds = (LAS unsigned char*)lds;
    F.tid = threadIdx.x; F.lane = F.tid & 63; F.wave = __builtin_amdgcn_readfirstlane(F.tid >> 6);
    F.G = gridDim.x; { const int bx = blockIdx.x; F.vcu = (F.G % 8 == 0) ? (bx % 8) * (F.G / 8) + bx / 8 : bx; }
    volatile LAS unsigned* MISC = (volatile LAS unsigned*)(F.lds + MISC_OFF);
    unsigned char* ws = args.ws;
    gu32* ctl = (gu32*)(ws + WS_CTL);
    const float* x = args.in[0]; float* out = args.out;
    bf16* WIN = (bf16*)(ws + WS_WIN); bf16* WAOUT = (bf16*)(ws + WS_WAOUT); bf16* WKVQZ = (bf16*)(ws + WS_WKVQZ); bf16* WBOUT = (bf16*)(ws + WS_WBOUT); bf16* WM = (bf16*)(ws + WS_WM);
    bf16* XN = (bf16*)(ws + WS_XN); bf16* U = (bf16*)(ws + WS_U); bf16* GV = (bf16*)(ws + WS_GV); bf16* SZ = (bf16*)(ws + WS_SZ);
    bf16* KB = (bf16*)(ws + WS_K); bf16* QO = (bf16*)(ws + WS_Q);
    float* SS1 = (float*)(ws + WS_SS1); float* SS2 = (float*)(ws + WS_SS2);
    const int lo = args.ph_lo, hi = args.ph_hi;
    const bool multi = (hi - lo) > 1;
    for (int u = F.tid; u < (LDS_BYTES - LDSCTL_OFF) / 4; u += NWAVES * 64) ((LAS unsigned*)(F.lds + LDSCTL_OFF))[u] = 0u;
    __syncthreads();
    XcdBarrier bar; bar.bar = (unsigned*)(ctl + CW_BAR); bar.x = 0; bar.st = nullptr;
    if (multi) bar = xcd_barrier_post((unsigned*)(ctl + CW_BAR), MISC + 8);
#define IN(k) (lo <= (k) && (k) < hi)
#define SEAM(k) do { if (IN(k) && IN((k) + 1)) xcd_barrier(bar); } while (0)

    if (IN(PH_PRO)) {
        P0Args a{x, args.in[1], args.in[2], args.in[5], args.in[7], args.in[8], args.in[9], args.in[10], args.in[11], args.in[13], WIN, WAOUT, WKVQZ, WBOUT, WM, XN};
        p0_prologue(F, a);
    }
    SEAM(PH_PRO);
    if (IN(PH_G1)) {
        pg8::Gemm g{XN, WIN, M, NIN, D}; pg8::StaticOrder S; S.init(M, NIN, F.G, (int)blockIdx.x);
        pg8::EpiAct1 E{U, GV, SZ, (pg8::f32x2e*)(ws + WS_VST)};
        pg8::gemm_phase<pg8::EpiAct1, pg8::StaticOrder, PG8_ALIGN, PG8_SP2>(F.lds + RING_OFF, g, S, E);
    }
    SEAM(PH_G1);
    if (IN(PH_MIX)) {   }
    SEAM(PH_MIX);
    if (IN(PH_G2)) {
        pg8::Gemm g{U, WAOUT, M, D, AW}; pg8::StaticOrder S; S.init(M, D, F.G, (int)blockIdx.x);
        pg8::EpiRes<true> E{x, out, XN, SS1};
        pg8::gemm_phase<pg8::EpiRes<true>, pg8::StaticOrder, PG8_ALIGN, PG8_SP2>(F.lds + RING_OFF, g, S, E);
    }
    SEAM(PH_G2);
    if (IN(PH_G3)) {
        pg8::Gemm g{XN, WKVQZ, M, 4096, D}; pg8::StaticOrder S; S.init(M, 4096, F.G, (int)blockIdx.x);
        pg8::EpiKVQZ E{KB, SS1, QSCALE};
        pg8::gemm_phase<pg8::EpiKVQZ, pg8::StaticOrder, PG8_ALIGN, PG8_SP2>(F.lds + RING_OFF, g, S, E);
    }
    SEAM(PH_G3);
    if (IN(PH_ATT)) {   }
    SEAM(PH_ATT);
    if (IN(PH_G4)) {
        pg8::Gemm g{QO, WBOUT, M, D, D}; pg8::StaticOrder S; S.init(M, D, F.G, (int)blockIdx.x);
        pg8::EpiRes<false> E{out, out, nullptr, SS2};
        pg8::gemm_phase<pg8::EpiRes<false>, pg8::StaticOrder, PG8_ALIGN, PG8_SP2>(F.lds + RING_OFF, g, S, E);
    }
    SEAM(PH_G4);
    if (IN(PH_FIN)) p7_final(F, out, SS2, args.in[14]);
#undef IN
#undef SEAM
}

extern "C" void kernel_launch(void* const* d_in, const int* in_sizes, int n_in, void* d_out, int out_size, void* d_ws, size_t ws_size, hipStream_t stream) {
    static int grid = 0;
    if (grid == 0) {
        if (n_in != 15 || in_sizes[0] != M * D || out_size != M * D || ws_size < WS_END) { fprintf(stderr, "kernel_launch: unexpected shapes (n_in %d in0 %d out %d ws %zu)\n", n_in, n_in > 0 ? in_sizes[0] : -1, out_size, ws_size); grid = -1; return; }
        int dev = 0, cus = 0, per_cu = 0;
        if (hipGetDevice(&dev) != hipSuccess || hipDeviceGetAttribute(&cus, hipDeviceAttributeMultiprocessorCount, dev) != hipSuccess) { grid = -1; return; }
        if (hipFuncSetAttribute((const void*)fwd, hipFuncAttributeMaxDynamicSharedMemorySize, LDS_BYTES) != hipSuccess) { fprintf(stderr, "kernel_launch: hipFuncSetAttribute failed\n"); grid = -1; return; }
        (void)hipFuncSetAttribute((const void*)k_mix_simple, hipFuncAttributeMaxDynamicSharedMemorySize, 140000);
        if (hipOccupancyMaxActiveBlocksPerMultiprocessor(&per_cu, (const void*)fwd, NWAVES * 64, LDS_BYTES) != hipSuccess || per_cu < 1) { fprintf(stderr, "kernel_launch: occupancy query says %d\n", per_cu); per_cu = 1; }
        (void)hipGetLastError();
        grid = cus;
    }
    if (grid < 0) return;
    (void)hipMemsetAsync((char*)d_ws + WS_CTL, 0, CTL_ZERO_BYTES, stream);
    Args a{};
    for (int i = 0; i < 15; ++i) a.in[i] = (const float*)d_in[i];
    a.out = (float*)d_out; a.ws = (unsigned char*)d_ws;
    unsigned char* ws = (unsigned char*)d_ws;
    auto run = [&](int lo, int hi) { a.ph_lo = lo; a.ph_hi = hi; hipLaunchKernelGGL(fwd, dim3(grid), dim3(NWAVES * 64), LDS_BYTES, stream, a); };
    run(PH_PRO, PH_PRO + 1);
    run(PH_G1, PH_G1 + 1);
    hipLaunchKernelGGL(k_mix_simple, dim3(AH, M / GL), dim3(512), 140000, stream, (const bf16*)(ws + WS_GV), (bf16*)(ws + WS_U), (const bf16*)(ws + WS_SZ), (const f32x2*)(ws + WS_VST),
                       (const bf16*)(ws + WS_WM), (const float*)d_in[3], (const float*)d_in[4], (const float*)d_in[6]);
    run(PH_G2, PH_G2 + 1);
    run(PH_G3, PH_G3 + 1);
    hipLaunchKernelGGL(k_attn_simple, dim3(SEQ / 64, BH, 4), dim3(256), 0, stream, (const bf16*)(ws + WS_K), (const bf16*)(ws + WS_V), (bf16*)(ws + WS_Q), (const bf16*)(ws + WS_ZB), (const float*)d_in[12]);
    run(PH_G4, PH_G4 + 1);
    run(PH_FIN, PH_FIN + 1);
}
```

```cpp
#include <hip/hip_runtime.h>
#include <cstdio>
#include <cstdint>
namespace pg8 {
#define PG8_LAS __attribute__((address_space(3)))
typedef unsigned short bf16_t;
typedef short bf16x8 __attribute__((ext_vector_type(8)));
typedef float f32x4 __attribute__((ext_vector_type(4)));
typedef unsigned u32x4 __attribute__((ext_vector_type(4)));
constexpr int BM = 256, BK = 64, HALF = 128, HTB = HALF * BK * 2  , STAGE_BYTES = 8 * HTB, NXCD = 8, WGM = 8;

__host__ __device__ __forceinline__ int lds_byte(int r, int c) { const int st = (r >> 4) * 2 + (c >> 5), rr = r & 15, cc = c & 31, ob = rr * 64 + cc * 2; return st * 1024 + (ob ^ (((ob >> 9) & 1) << 5)); }
__host__ __device__ __forceinline__ void stage_rc(int b, int& R, int& C) { const int st = b / 1024, sb = b % 1024, swz = sb ^ (((sb >> 9) & 1) << 5); R = (st >> 1) * 16 + swz / 64; C = (st & 1) * 32 + (swz % 64) / 2; }
__host__ __device__ __forceinline__ int perm32(int rho) { const int n = rho >> 4, i = rho & 15; return 8 * (i >> 2) + 4 * n + (i & 3); }

struct Unit { int pm, pn; };
struct Gemm { const bf16_t* A; const bf16_t* Bt; int M, N, K; };

struct StaticOrder {
    int nM, nN, nwg, G, c;
    __host__ __device__ void init(int M, int N, int G_, int c_) { nM = M / BM; nN = N / BM; nwg = nM * nN; G = G_; c = c_; }
    __host__ __device__ bool next(int i, Unit& u) const {
        const long L = (long)i * G + c; if (L >= nwg) return false;
        int wgid = (int)L; { const int q = nwg / NXCD, r = nwg % NXCD, xcd = wgid % NXCD, off = wgid / NXCD; wgid = (xcd < r ? xcd * (q + 1) : r * (q + 1) + (xcd - r) * q) + off; }
        const int nig = WGM * nN, gid = wgid / nig, fm = gid * WGM, gsz = (nM - fm) < WGM ? (nM - fm) : WGM;
        u.pm = fm + ((wgid % nig) % gsz); u.pn = (wgid % nig) / gsz; return true;
    }
    __device__ __forceinline__ void a_ready(const Unit&) const {}
    __device__ __forceinline__ void done(const Unit&) const {}
};
__device__ __forceinline__ unsigned cvt_pk_bf16(float lo, float hi) { unsigned r; asm volatile("v_cvt_pk_bf16_f32 %0, %1, %2" : "=v"(r) : "v"(lo), "v"(hi)); return r; }
template <class Epi, class Sched, bool ALIGN_EPI = false, bool SP2 = false>
__device__ __forceinline__ void gemm_phase(PG8_LAS unsigned char* lds, const Gemm g, const Sched& S, const Epi& E) {
    const int tid = threadIdx.x, wid = __builtin_amdgcn_readfirstlane(tid >> 6), lane = tid & 63, wr = wid >> 2, wc = wid & 3, fr = lane & 15, fq = lane >> 4;
    const int K = g.K, nt = K / BK;
    unsigned voffA[2], voffB[2];
#pragma unroll
    for (int i = 0; i < 2; ++i) { int R, C; stage_rc(tid * 16 + i * 8192, R, C); const int Rb = Epi::PERM ? ((R & ~31) + perm32(R & 31)) : R;
        voffA[i] = (unsigned)(R * K + C) * 2u; voffB[i] = (unsigned)(Rb * K + C) * 2u; }
    const size_t kstep = (size_t)(BK * 2);
    const size_t hstep = (size_t)HALF * K * 2;
    const size_t tstep = 2 * hstep;
    const unsigned ldsw = (unsigned)wid * 1024u;
    const int aoff = lds_byte(wr * 64 + fr, fq * 8), boff = lds_byte(wc * 32 + fr, fq * 8);
#define PG8_SA(b, h) (((b) * 2 + (h)) * HTB)
#define PG8_SB(b, h) ((4 + (b) * 2 + (h)) * HTB)
#define PG8_STAGE(bufoff, gbase, voff) do { _Pragma("unroll") for (int _i = 0; _i < 2; ++_i) \
        __builtin_amdgcn_global_load_lds((const unsigned*)((const char*)(gbase) + (voff)[_i]), (PG8_LAS unsigned*)(lds + (bufoff) + ldsw + _i * 8192), 16, 0, 0); } while (0)
#define PG8_LDA(dst, b, h) do { _Pragma("unroll") for (int m = 0; m < 4; ++m) _Pragma("unroll") for (int k = 0; k < 2; ++k) dst[m][k] = *(const PG8_LAS bf16x8*)(lds + PG8_SA(b, h) + aoff + m * 2048 + k * 1024); } while (0)
#define PG8_LDB(dst, b, h) do { _Pragma("unroll") for (int n = 0; n < 2; ++n) _Pragma("unroll") for (int k = 0; k < 2; ++k) dst[n][k] = *(const PG8_LAS bf16x8*)(lds + PG8_SB(b, h) + boff + n * 2048 + k * 1024); } while (0)
#define PG8_MMA(ai, bj, At, Bt) do { __builtin_amdgcn_s_setprio(1); _Pragma("unroll") for (int m = 0; m < 4; ++m) _Pragma("unroll") for (int n = 0; n < 2; ++n) _Pragma("unroll") for (int k = 0; k < 2; ++k) \
        acc[ai][bj][m][n] = __builtin_amdgcn_mfma_f32_16x16x32_bf16(Bt[n][k], At[m][k], acc[ai][bj][m][n], 0, 0, 0); __builtin_amdgcn_s_setprio(0); } while (0)
#define PG8_WAIT_V(n) asm volatile("s_waitcnt vmcnt(" #n ")" ::: "memory")
#define PG8_WAIT_L(n) asm volatile("s_waitcnt lgkmcnt(" #n ")" ::: "memory")
#define PG8_BAR __builtin_amdgcn_s_barrier()
#define PG8_SCHED __builtin_amdgcn_sched_barrier(0)
    Unit cur, nxt; int ui = 0;
    if (!S.next(0, cur)) return;
    f32x4 acc[2][2][4][2];
#pragma unroll
    for (int a = 0; a < 2; ++a)
#pragma unroll
        for (int b = 0; b < 2; ++b)
#pragma unroll
            for (int m = 0; m < 4; ++m)
#pragma unroll
                for (int n = 0; n < 2; ++n) acc[a][b][m][n] = (f32x4){0.f, 0.f, 0.f, 0.f};
    bf16x8 At[4][2], B0[2][2], B1[2][2];
    const char* cA = (const char*)g.A + (size_t)cur.pm * tstep; const char* cB = (const char*)g.Bt + (size_t)cur.pn * tstep;
    S.a_ready(cur);
    if constexpr (SP2) {
        PG8_STAGE(PG8_SB(0, 0), cB, voffB); PG8_STAGE(PG8_SB(0, 1), cB + hstep, voffB); PG8_STAGE(PG8_SA(0, 0), cA, voffA); PG8_STAGE(PG8_SA(0, 1), cA + hstep, voffA);
        if (wr == 1) PG8_BAR;
        PG8_WAIT_V(2); PG8_BAR;
        PG8_STAGE(PG8_SB(1, 0), cB + kstep, voffB); PG8_STAGE(PG8_SA(1, 0), cA + kstep, voffA); PG8_STAGE(PG8_SB(1, 1), cB + hstep + kstep, voffB);
        PG8_WAIT_V(6); PG8_BAR;
    } else {
        PG8_STAGE(PG8_SB(0, 0), cB, voffB); PG8_STAGE(PG8_SA(0, 0), cA, voffA); PG8_STAGE(PG8_SB(0, 1), cB + hstep, voffB); PG8_STAGE(PG8_SA(0, 1), cA + hstep, voffA);
        if (wr == 1) PG8_BAR;
        PG8_WAIT_V(4); PG8_BAR;
        PG8_STAGE(PG8_SB(1, 0), cB + kstep, voffB); PG8_STAGE(PG8_SA(1, 0), cA + kstep, voffA); PG8_STAGE(PG8_SB(1, 1), cB + hstep + kstep, voffB);
        PG8_WAIT_V(6); PG8_BAR;
    }
    for (;;) {
        const bool has_next = S.next(ui + 1, nxt);
        const char* nA = has_next ? (const char*)g.A + (size_t)nxt.pm * tstep : cA; const char* nB = has_next ? (const char*)g.Bt + (size_t)nxt.pn * tstep : cB;
        for (int t = 0; t < nt; t += 2) {
            const bool last = (t == nt - 2);
            const char* a1 = cA + (size_t)(t + 1) * kstep;
            const char* a2 = last ? nA : cA + (size_t)(t + 2) * kstep; const char* b2 = last ? nB : cB + (size_t)(t + 2) * kstep;
            const char* a3 = a2 + kstep; const char* b3 = b2 + kstep;
            if (last && has_next) S.a_ready(nxt);
            if constexpr (SP2) {
            PG8_LDB(B0, 0, 0); PG8_LDB(B1, 0, 1); PG8_SCHED; PG8_LDA(At, 0, 0); PG8_STAGE(PG8_SA(1, 1), a1 + hstep, voffA);
            PG8_WAIT_V(8); PG8_WAIT_L(0); PG8_BAR; PG8_MMA(0, 0, At, B0); PG8_MMA(0, 1, At, B1); PG8_BAR; PG8_SCHED;
            PG8_LDA(At, 0, 1); PG8_STAGE(PG8_SB(0, 0), b2, voffB); PG8_STAGE(PG8_SB(0, 1), b2 + hstep, voffB); PG8_STAGE(PG8_SA(0, 0), a2, voffA);
            PG8_WAIT_V(8); PG8_WAIT_L(0); PG8_BAR; PG8_MMA(1, 0, At, B0); PG8_MMA(1, 1, At, B1); PG8_BAR; PG8_SCHED;
            PG8_LDB(B0, 1, 0); PG8_LDB(B1, 1, 1); PG8_SCHED; PG8_LDA(At, 1, 0); PG8_STAGE(PG8_SA(0, 1), a2 + hstep, voffA);
            PG8_WAIT_V(8); PG8_WAIT_L(0); PG8_BAR; PG8_MMA(0, 0, At, B0); PG8_MMA(0, 1, At, B1); PG8_BAR; PG8_SCHED;
            PG8_LDA(At, 1, 1); PG8_STAGE(PG8_SB(1, 0), b3, voffB); PG8_STAGE(PG8_SB(1, 1), b3 + hstep, voffB); PG8_STAGE(PG8_SA(1, 0), a3, voffA);
            PG8_WAIT_V(8); PG8_WAIT_L(0); PG8_BAR; PG8_MMA(1, 0, At, B0); PG8_MMA(1, 1, At, B1); PG8_BAR; PG8_SCHED;
            } else {
            PG8_LDB(B0, 0, 0); PG8_SCHED; PG8_LDA(At, 0, 0); PG8_STAGE(PG8_SA(1, 1), a1 + hstep, voffA);
            PG8_WAIT_L(8); PG8_BAR; PG8_WAIT_L(0); PG8_MMA(0, 0, At, B0); PG8_BAR; PG8_SCHED;
            PG8_LDB(B1, 0, 1); PG8_STAGE(PG8_SB(0, 0), b2, voffB);
            PG8_BAR; PG8_WAIT_L(0); PG8_MMA(0, 1, At, B1); PG8_BAR;
            PG8_LDA(At, 0, 1); PG8_STAGE(PG8_SA(0, 0), a2, voffA);
            PG8_BAR; PG8_WAIT_L(0); PG8_MMA(1, 0, At, B0); PG8_BAR; PG8_SCHED;
            PG8_STAGE(PG8_SB(0, 1), b2 + hstep, voffB);
            PG8_WAIT_V(6); PG8_BAR; PG8_MMA(1, 1, At, B1); PG8_BAR;
            PG8_LDB(B0, 1, 0); PG8_SCHED; PG8_LDA(At, 1, 0); PG8_STAGE(PG8_SA(0, 1), a2 + hstep, voffA);
            PG8_WAIT_L(8); PG8_BAR; PG8_WAIT_L(0); PG8_MMA(0, 0, At, B0); PG8_BAR; PG8_SCHED;
            PG8_LDB(B1, 1, 1); PG8_STAGE(PG8_SB(1, 0), b3, voffB);
            PG8_BAR; PG8_WAIT_L(0); PG8_MMA(0, 1, At, B1); PG8_BAR;
            PG8_LDA(At, 1, 1); PG8_STAGE(PG8_SA(1, 0), a3, voffA);
            PG8_BAR; PG8_WAIT_L(0); PG8_MMA(1, 0, At, B0); PG8_BAR; PG8_SCHED;
            PG8_STAGE(PG8_SB(1, 1), b3 + hstep, voffB);
            PG8_WAIT_V(6); PG8_BAR; PG8_MMA(1, 1, At, B1); PG8_BAR;
            }
        }
        if constexpr (ALIGN_EPI) { if (wr == 0) PG8_BAR; }
        if constexpr (!Epi::AFTER_DRAIN) { E(acc, cur, wr, wc, fr, fq); S.done(cur); }
        if (!has_next) break;
#pragma unroll
        for (int a = 0; a < 2; ++a)
#pragma unroll
            for (int b = 0; b < 2; ++b)
#pragma unroll
                for (int m = 0; m < 4; ++m)
#pragma unroll
                    for (int n = 0; n < 2; ++n) acc[a][b][m][n] = (f32x4){0.f, 0.f, 0.f, 0.f};
        cur = nxt; cA = nA; cB = nB; ++ui;
        if constexpr (ALIGN_EPI) { if (wr == 1) PG8_BAR; }
    }
    PG8_WAIT_V(0);
    if constexpr (!ALIGN_EPI) { if (wr == 0) PG8_BAR; }
    PG8_BAR;
    if constexpr (Epi::AFTER_DRAIN) { E.fused(acc, cur, wr, wc, fr, fq, lds, wid, lane); S.done(cur); }
#undef PG8_SA
#undef PG8_SB
#undef PG8_STAGE
#undef PG8_LDA
#undef PG8_LDB
#undef PG8_MMA
#undef PG8_WAIT_V
#undef PG8_WAIT_L
#undef PG8_BAR
#undef PG8_SCHED
}
}
namespace pg8 {
typedef float f32x2e __attribute__((ext_vector_type(2)));
__device__ __forceinline__ float fast_gelu(float x) {
    const float t = x * __builtin_fmaf(x * x, 0.10294324f, 2.30220820f);
    return x * __builtin_amdgcn_rcpf(1.f + __builtin_amdgcn_exp2f(-t));
}
__device__ __forceinline__ float fast_silu(float x) { return x * __builtin_amdgcn_rcpf(1.f + __builtin_amdgcn_exp2f(-1.4426950409f * x)); }

struct EpiAct1 {
    static constexpr bool PERM = true, AFTER_DRAIN = false;
    bf16_t* U; bf16_t* GV; bf16_t* SZ; f32x2e* VST;
    template <int KIND> __device__ __forceinline__ void body(const f32x4 (&acc)[2][2][4][2], const Unit& u, int wr, int wc, int fr, int fq) const {
        const int pt = u.pn & 7;
        bf16_t* base = KIND == 0 ? U : (KIND == 1 ? GV : SZ);
        const int row0 = u.pm * BM + wr * 64 + fr, col0 = pt * BM + wc * 32 + 8 * fq;
#pragma unroll
        for (int ai = 0; ai < 2; ++ai)
#pragma unroll
            for (int m = 0; m < 4; ++m) {
                const int row = row0 + ai * HALF + m * 16; bf16_t* rowp = base + (size_t)row * 2048 + col0;
                float s = 0.f, q = 0.f;
#pragma unroll
                for (int bj = 0; bj < 2; ++bj) {
                    f32x4 v0 = acc[ai][bj][m][0], v1 = acc[ai][bj][m][1];
#pragma unroll
                    for (int j = 0; j < 4; ++j) { v0[j] = KIND == 2 ? fast_silu(v0[j]) : fast_gelu(v0[j]); v1[j] = KIND == 2 ? fast_silu(v1[j]) : fast_gelu(v1[j]); }
                    if (KIND == 1) {
                        s += ((v0[0] + v0[1]) + (v0[2] + v0[3])) + ((v1[0] + v1[1]) + (v1[2] + v1[3]));
                        q += ((v0[0] * v0[0] + v0[1] * v0[1]) + (v0[2] * v0[2] + v0[3] * v0[3])) + ((v1[0] * v1[0] + v1[1] * v1[1]) + (v1[2] * v1[2] + v1[3] * v1[3]));
                    }
                    u32x4 w; w.x = cvt_pk_bf16(v0[0], v0[1]); w.y = cvt_pk_bf16(v0[2], v0[3]); w.z = cvt_pk_bf16(v1[0], v1[1]); w.w = cvt_pk_bf16(v1[2], v1[3]);
                    *(u32x4*)(rowp + bj * HALF) = w;
                }
                if (KIND == 1) {
                    s += __shfl_xor(s, 16); s += __shfl_xor(s, 32); q += __shfl_xor(q, 16); q += __shfl_xor(q, 32);
                    if (fq == 0) VST[(size_t)row * 32 + pt * 4 + wc] = (f32x2e){s, q};
                }
            }
    }
    __device__ __forceinline__ void operator()(const f32x4 (&acc)[2][2][4][2], const Unit& u, int wr, int wc, int fr, int fq) const {
        const int kind = u.pn >> 3;
        if (kind == 0) body<0>(acc, u, wr, wc, fr, fq); else if (kind == 1) body<1>(acc, u, wr, wc, fr, fq); else body<2>(acc, u, wr, wc, fr, fq);
    }
};
template <bool WRITE_BF16> struct EpiRes {
    static constexpr bool PERM = false, AFTER_DRAIN = false;
    const float* res; float* out; bf16_t* XB; float* SS;
    __device__ __forceinline__ void operator()(const f32x4 (&acc)[2][2][4][2], const Unit& u, int wr, int wc, int fr, int fq) const {
        const int row0 = u.pm * BM + wr * 64 + fr, col0 = u.pn * BM + wc * 32 + 4 * fq;
#pragma unroll
        for (int ai = 0; ai < 2; ++ai)
#pragma unroll
            for (int m = 0; m < 4; ++m) {
                const int row = row0 + ai * HALF + m * 16; const size_t off = (size_t)row * 1024 + col0; float ss = 0.f;
#pragma unroll
                for (int bj = 0; bj < 2; ++bj)
#pragma unroll
                    for (int n = 0; n < 2; ++n) {
                        const f32x4 r = *(const f32x4*)(res + off + bj * HALF + n * 16); const f32x4 v = r + acc[ai][bj][m][n];
                        *(f32x4*)(out + off + bj * HALF + n * 16) = v;
                        ss += (v[0] * v[0] + v[1] * v[1]) + (v[2] * v[2] + v[3] * v[3]);
                        if (WRITE_BF16) { f32x2e w; unsigned w0 = cvt_pk_bf16(v[0], v[1]), w1 = cvt_pk_bf16(v[2], v[3]); typedef unsigned u32x2e __attribute__((ext_vector_type(2))); *(u32x2e*)(XB + off + bj * HALF + n * 16) = (u32x2e){w0, w1}; (void)w; }
                    }
                ss += __shfl_xor(ss, 16); ss += __shfl_xor(ss, 32);
                if (fq == 0) SS[(size_t)row * 16 + u.pn * 4 + wc] = ss;
            }
    }
};
struct EpiKVQZ {
    static constexpr bool PERM = true, AFTER_DRAIN = false;
    bf16_t* KVQZ; const float* SS; float qscale;
    __device__ __forceinline__ void operator()(const f32x4 (&acc)[2][2][4][2], const Unit& u, int wr, int wc, int fr, int fq) const {
        const int kind = u.pn >> 2, pt = u.pn & 3;
        bf16_t* base = KVQZ + (size_t)kind * ((size_t)16384 * 1024);
        const int row0 = u.pm * BM + wr * 64 + fr, col0 = pt * BM + wc * 32 + 8 * fq;
#pragma unroll
        for (int ai = 0; ai < 2; ++ai)
#pragma unroll
            for (int m = 0; m < 4; ++m) {
                const int row = row0 + ai * HALF + m * 16; bf16_t* rowp = base + (size_t)row * 1024 + col0;
                const f32x4* sp = (const f32x4*)(SS + (size_t)row * 16); const f32x4 s0 = sp[0], s1 = sp[1], s2 = sp[2], s3 = sp[3];
                const float tot = (((s0[0] + s0[1]) + (s0[2] + s0[3])) + ((s1[0] + s1[1]) + (s1[2] + s1[3]))) + (((s2[0] + s2[1]) + (s2[2] + s2[3])) + ((s3[0] + s3[1]) + (s3[2] + s3[3])));
                float rs = __builtin_amdgcn_rsqf(tot * (1.f / 1024.f) + 1e-6f); if (kind == 2) rs *= qscale;
#pragma unroll
                for (int bj = 0; bj < 2; ++bj) {
                    f32x4 v0 = acc[ai][bj][m][0] * rs, v1 = acc[ai][bj][m][1] * rs;
                    if (kind == 3) {
#pragma unroll
                        for (int j = 0; j < 4; ++j) { v0[j] = fast_silu(v0[j]); v1[j] = fast_silu(v1[j]); }
                    }
                    u32x4 w; w.x = cvt_pk_bf16(v0[0], v0[1]); w.y = cvt_pk_bf16(v0[2], v0[3]); w.z = cvt_pk_bf16(v1[0], v1[1]); w.w = cvt_pk_bf16(v1[2], v1[3]);
                    *(u32x4*)(rowp + bj * HALF) = w;
                }
            }
    }
};
}
#ifndef PG8_SP2
#define PG8_SP2 true
#endif
#ifndef PG8_ALIGN
#define PG8_ALIGN true
#endif
constexpr int NWAVES = 8;
constexpr int M = 16384, D = 1024, SEQ = 4096, AW = 2048, NIN = 3 * AW;
constexpr int GL = 128, AH = 16, HC = 128;
constexpr int BH = 16, HD = 64, NREL = 513;
constexpr float NORM_EPS = 1e-6f;
constexpr float QSCALE = 0.125f * 1.4426950408889634f;
constexpr float LOG2E = 1.4426950408889634f;
constexpr size_t MiB = 1u << 20;
constexpr size_t WS_CTL = 0, CTL_ZERO_BYTES = 32768;
constexpr size_t WS_WIN = 1 * MiB, WS_WAOUT = 13 * MiB, WS_WKVQZ = 17 * MiB, WS_WBOUT = 25 * MiB, WS_WM = 27 * MiB;
constexpr size_t WS_VST = 28 * MiB;
constexpr size_t WS_SS1 = 28 * MiB, WS_SS2 = 29 * MiB;
constexpr size_t WS_XN = 32 * MiB;
constexpr size_t WS_U = 64 * MiB, WS_GV = 128 * MiB, WS_SZ = 192 * MiB;
constexpr size_t WS_K = 64 * MiB, WS_V = 96 * MiB, WS_Q = 128 * MiB, WS_ZB = 160 * MiB;
constexpr size_t WS_END = 256 * MiB;
constexpr int CW_BAR = 4096;
constexpr int RING_OFF = 0, RING_BYTES = 131072;
constexpr int LDSCTL_OFF = RING_BYTES, MISC_OFF = LDSCTL_OFF + 320;
constexpr int LDS_BYTES = 147456;

#define GAS __attribute__((address_space(1)))
#define LAS __attribute__((address_space(3)))
typedef unsigned short bf16;
typedef unsigned v4u __attribute__((ext_vector_type(4)));
typedef unsigned v2u __attribute__((ext_vector_type(2)));
typedef float f32x4 __attribute__((ext_vector_type(4)));
typedef float f32x2 __attribute__((ext_vector_type(2)));
typedef short bf16x8 __attribute__((ext_vector_type(8)));
typedef GAS unsigned gu32;
typedef GAS unsigned long long gu64;
#define RLX_AGENT __ATOMIC_RELAXED, __HIP_MEMORY_SCOPE_AGENT
#define LDS_WAIT() asm volatile("s_waitcnt lgkmcnt(0)" ::: "memory")
#define VM_WAIT() asm volatile("s_waitcnt vmcnt(0)" ::: "memory")
__device__ __forceinline__ unsigned f2bf(float f) { unsigned u = __builtin_bit_cast(unsigned, f); return (u + 0x7fffu + ((u >> 16) & 1u)) >> 16; }
__device__ __forceinline__ unsigned pk2(float lo, float hi) { return f2bf(lo) | (f2bf(hi) << 16); }
__device__ __forceinline__ float bf2f(unsigned short b) { return __builtin_bit_cast(float, (unsigned)b << 16); }
__device__ __forceinline__ float bflo(unsigned w) { return __builtin_bit_cast(float, w << 16); }
__device__ __forceinline__ float bfhi(unsigned w) { return __builtin_bit_cast(float, w & 0xffff0000u); }
#define XB_TMO      128
#define XB_XCNT(j)  (256  + 64 * (j))
#define XB_XSUB(j)  (1280 + 64 * (j))
#define XB_XGEN(j)  (2304 + 64 * (j))
#define XB_TOP      3328
#define XB_TOPGEN   3392
#define XCD_BAR_WORDS 3456
#define XB_SPIN_CAP (1u << 18)

__device__ __forceinline__ unsigned xb_ld(unsigned* p)              { return __hip_atomic_load(p, __ATOMIC_RELAXED, __HIP_MEMORY_SCOPE_AGENT); }
__device__ __forceinline__ unsigned xb_add(unsigned* p, unsigned v) { return __hip_atomic_fetch_add(p, v, __ATOMIC_RELAXED, __HIP_MEMORY_SCOPE_AGENT); }
__device__ __forceinline__ unsigned xb_xcc_id() { return (unsigned)__builtin_amdgcn_s_getreg((3 << 11) | 20) & 0xFu; }
#define XB_SPIN(cond, bar) do { unsigned _sp = 0; while (cond) { __builtin_amdgcn_s_sleep(1); \
    if ((++_sp & 255u) == 0u) { if (xb_ld(&(bar)[XB_TMO])) break; if (_sp > XB_SPIN_CAP) { atomicAdd(&(bar)[XB_TMO], 1u); break; } } } } while (0)

struct XcdBarrier {
    unsigned* bar; unsigned x;
    volatile LAS unsigned* st;
};

__device__ __forceinline__ XcdBarrier xcd_barrier_post(unsigned* bar, volatile LAS unsigned* st) {
    XcdBarrier b; b.bar = bar; b.x = xb_xcc_id(); b.st = st;
    if (threadIdx.x == 0) (void)xb_add(&bar[XB_XCNT(b.x)], 1u);
    return b;
}
__device__ __forceinline__ void xcd_barrier_complete(unsigned* bar, unsigned x, unsigned& nloc, unsigned& nx) {
    const unsigned G = gridDim.x * gridDim.y * gridDim.z;
    unsigned sum, cnt, mine, sp = 0u;
    for (;;) {
        sum = 0u; cnt = 0u; mine = 0u;
#pragma unroll
        for (unsigned j = 0; j < 16; ++j) { const unsigned c = xb_ld(&bar[XB_XCNT(j)]); sum += c; cnt += (c > 0u) ? 1u : 0u; mine = (j == x) ? c : mine; }
        if (sum == G) break;
        __builtin_amdgcn_s_sleep(1);
        if ((++sp & 255u) == 0u) { if (xb_ld(&bar[XB_TMO])) break; if (sp > XB_SPIN_CAP) { atomicAdd(&bar[XB_TMO], 1u); break; } }
    }
    nloc = mine > 0u ? mine : 1u; nx = cnt > 0u ? cnt : 1u;
}

__device__ __forceinline__ void xcd_barrier(const XcdBarrier& b) {
    asm volatile("s_waitcnt vmcnt(0)" ::: "memory");
    __syncthreads();
    if (threadIdx.x == 0) {
        unsigned* bar = b.bar;
        __builtin_amdgcn_s_waitcnt(0);
        unsigned nloc = b.st[0], nx = b.st[1];
        if (nloc == 0u) { xcd_barrier_complete(bar, b.x, nloc, nx); b.st[0] = nloc; b.st[1] = nx; }
        const unsigned old = xb_add(&bar[XB_XSUB(b.x)], 1u);
        const unsigned gen = old / nloc;
        if (old + 1u == (gen + 1u) * nloc) {
            __builtin_amdgcn_fence(__ATOMIC_RELEASE, "agent");
            asm volatile("s_waitcnt vmcnt(0)" ::: "memory");
            const unsigned og = xb_add(&bar[XB_TOP], 1u);
            const unsigned tg = og / nx;
            if (og + 1u == (tg + 1u) * nx) xb_add(&bar[XB_TOPGEN], 1u);
            else XB_SPIN(xb_ld(&bar[XB_TOPGEN]) == tg, bar);
            __builtin_amdgcn_fence(__ATOMIC_ACQUIRE, "agent");
            xb_add(&bar[XB_XGEN(b.x)], 1u);
            asm volatile("s_waitcnt vmcnt(0)" ::: "memory");
        } else {
            XB_SPIN(xb_ld(&bar[XB_XGEN(b.x)]) == gen, bar);
            __builtin_amdgcn_fence(__ATOMIC_ACQUIRE, "agent");
            asm volatile("s_waitcnt vmcnt(0)" ::: "memory");
        }
    }
    __syncthreads();
}
struct Ctx {
    LAS unsigned char* lds; int tid, lane, wave, vcu, G;
};
__device__ __forceinline__ float wave_sum(float v) {
#pragma unroll
    for (int o = 1; o < 64; o <<= 1) v += __shfl_xor(v, o);
    return v;
}
__device__ __forceinline__ void p0_transpose_item(const float* W, int K, int N, bf16* WT, int row_off, const float* gain, LAS float* scr, int item, int lane) {
    const int nblk = N / 32, kb = item / nblk, nb = item % nblk, k0 = 64 * kb, n0 = 32 * nb;
#pragma unroll 8
    for (int i = 0; i < 32; ++i) { const int kk = 2 * i + (lane >> 5); float w = W[(size_t)(k0 + kk) * N + n0 + (lane & 31)]; if (gain) w *= gain[k0 + kk]; scr[kk * 33 + (lane & 31)] = w; }
    LDS_WAIT(); asm volatile("" ::: "memory");
    const int c = lane & 7;
#pragma unroll
    for (int j = 0; j < 4; ++j) { const int n = (lane >> 3) + 8 * j; const LAS float* s = scr + (8 * c) * 33 + n;
        v4u o; o.x = pk2(s[0 * 33], s[1 * 33]); o.y = pk2(s[2 * 33], s[3 * 33]); o.z = pk2(s[4 * 33], s[5 * 33]); o.w = pk2(s[6 * 33], s[7 * 33]);
        *(GAS v4u*)(WT + (size_t)(row_off + n0 + n) * K + k0 + 8 * c) = o; }
    LDS_WAIT(); asm volatile("" ::: "memory");
}
__device__ __forceinline__ void rms_row_to_bf16(int lane, const float* xrow, const float* g, bf16* orow) {
    const GAS f32x4* xr = (const GAS f32x4*)xrow + lane; const GAS f32x4* gr = (const GAS f32x4*)g + lane;
    f32x4 v[4]; float s = 0.f;
#pragma unroll
    for (int j = 0; j < 4; ++j) { v[j] = xr[64 * j]; s += (v[j].x * v[j].x + v[j].y * v[j].y) + (v[j].z * v[j].z + v[j].w * v[j].w); }
    const float rstd = 1.f / sqrtf(wave_sum(s) * (1.f / D) + NORM_EPS);
    GAS unsigned long long* o8 = (GAS unsigned long long*)orow + lane;
#pragma unroll
    for (int j = 0; j < 4; ++j) { const f32x4 gg = gr[64 * j];
        o8[64 * j] = (unsigned long long)pk2(v[j].x * rstd * gg.x, v[j].y * rstd * gg.y) | ((unsigned long long)pk2(v[j].z * rstd * gg.z, v[j].w * rstd * gg.w) << 32); }
}
struct P0Args { const float *x, *a_norm_g, *a_w_in, *a_w_s, *a_w_out, *kv_norm_g, *w_kv, *b_norm_g, *b_w_qz, *b_w_out; bf16 *WIN, *WAOUT, *WKVQZ, *WBOUT, *WM, *XN; };
__device__ __forceinline__ void p0_prologue(const Ctx& F, const P0Args& a) {
    LAS float* scr = (LAS float*)(F.lds + RING_OFF + F.wave * 16384);
    const int gw = F.vcu * NWAVES + F.wave, NGW = F.G * NWAVES;
    constexpr int I_IN = (D / 64) * (NIN / 32), I_AO = (AW / 64) * (D / 32), I_KV = (D / 64) * (2048 / 32), I_QZ = I_KV, I_BO = (D / 64) * (D / 32);
    constexpr int NITEMS = I_IN + I_AO + I_KV + I_QZ + I_BO;
    for (int it = gw; it < NITEMS; it += NGW) {
        int r = it;
        if (r < I_IN) { p0_transpose_item(a.a_w_in, D, NIN, a.WIN, 0, nullptr, scr, r, F.lane); continue; } r -= I_IN;
        if (r < I_AO) { p0_transpose_item(a.a_w_out, AW, D, a.WAOUT, 0, nullptr, scr, r, F.lane); continue; } r -= I_AO;
        if (r < I_KV) { p0_transpose_item(a.w_kv, D, 2048, a.WKVQZ, 0, a.kv_norm_g, scr, r, F.lane); continue; } r -= I_KV;
        if (r < I_QZ) { p0_transpose_item(a.b_w_qz, D, 2048, a.WKVQZ, 2048, a.b_norm_g, scr, r, F.lane); continue; } r -= I_QZ;
        p0_transpose_item(a.b_w_out, D, D, a.WBOUT, 0, nullptr, scr, r, F.lane);
    }
    for (int i = (F.vcu * NWAVES * 64 + F.tid); i < AH * GL * GL / 2; i += F.G * NWAVES * 64) {
        const int e = 2 * i, s = e & 127, t = (e >> 7) & 127; const f32x2 w = *(const GAS f32x2*)(a.a_w_s + e);
        const bool ok = (t >> 6) >= (s >> 6);
        *(GAS unsigned*)(a.WM + e) = ok ? pk2(w.x, w.y) : 0u;
    }
    for (int m = gw; m < M; m += NGW) rms_row_to_bf16(F.lane, a.x + (size_t)m * D, a.a_norm_g, a.XN + (size_t)m * D);
}
__device__ __forceinline__ void p7_final(const Ctx& F, float* out, const float* SS2, const float* g) {
    const int gw = F.vcu * NWAVES + F.wave, NGW = F.G * NWAVES;
    for (int m = gw; m < M; m += NGW) {
        float s = SS2[(size_t)m * 16 + (F.lane & 15)];
        s += __shfl_xor(s, 1); s += __shfl_xor(s, 2); s += __shfl_xor(s, 4); s += __shfl_xor(s, 8);
        const float rstd = 1.f / sqrtf(s * (1.f / D) + NORM_EPS);
        GAS f32x4* xr = (GAS f32x4*)(out + (size_t)m * D) + F.lane; const GAS f32x4* gr = (const GAS f32x4*)g + F.lane;
#pragma unroll
        for (int j = 0; j < 4; ++j) { const f32x4 v = xr[64 * j], gg = gr[64 * j]; xr[64 * j] = v * rstd * gg; }
    }
}
typedef short v4i16_t __attribute__((ext_vector_type(4)));
typedef short s16x4 __attribute__((ext_vector_type(4)));
__device__ __forceinline__ s16x4 vtr(const LAS unsigned char* p) { return __builtin_bit_cast(s16x4, __builtin_amdgcn_ds_read_tr16_b64_v4i16((LAS v4i16_t*)p)); }
__device__ __forceinline__ unsigned cvtpk(float lo, float hi) { typedef float f2_t __attribute__((ext_vector_type(2))); typedef __bf16 b2_t __attribute__((ext_vector_type(2))); f2_t v = {lo, hi}; b2_t b = __builtin_convertvector(v, b2_t); return __builtin_bit_cast(unsigned, b); }
constexpr int MIX_VN = 0, MIX_ST = 32768;
__device__ __forceinline__ void p2_mix(const Ctx& F, const bf16* GV, bf16* UY, const bf16* SZ, const f32x2* VST, const bf16* WM, const float* ln_g, const float* ln_b, const float* b_s) {
    const int tid = F.tid, lane = F.lane, w = F.wave, fr = lane & 15, fq = lane >> 4;
    LAS unsigned char* vn = F.lds + RING_OFF + MIX_VN;
    LAS float* st = (LAS float*)(F.lds + RING_OFF + MIX_ST);
    const int c8 = tid & 15, srow = tid >> 4;
    const int q = (lane & 15) >> 2, p = lane & 3;
    unsigned rdb[4][2];
#pragma unroll
    for (int a = 0; a < 4; ++a)
#pragma unroll
        for (int t = 0; t < 2; ++t) rdb[a][t] = (unsigned)((8 * fq + q) * 256 + ((64 * (a ^ q) + 16 * p + 8 * t) ^ ((fq & 1) << 3)));
    int cur_head = -1; bf16x8 wf[4]; float bias = 0.f; f32x4 lg0, lg1, lb0, lb1;
    for (int n = F.vcu; n < (M / GL) * AH; n += F.G) {
        const int head = n & 15, grp = n >> 4;
        if (head != cur_head) {
#pragma unroll
            for (int ks = 0; ks < 4; ++ks) wf[ks] = *(const GAS bf16x8*)(WM + (size_t)head * (GL * GL) + (16 * w + fr) * GL + 32 * ks + 8 * fq);
            bias = b_s[head * GL + 16 * w + fr];
            lg0 = *(const GAS f32x4*)(ln_g + head * HC + c8 * 8); lg1 = *(const GAS f32x4*)(ln_g + head * HC + c8 * 8 + 4);
            lb0 = *(const GAS f32x4*)(ln_b + head * HC + c8 * 8); lb1 = *(const GAS f32x4*)(ln_b + head * HC + c8 * 8 + 4);
            cur_head = head;
        }
        const size_t rowbase = (size_t)grp * GL;
        v4u gvr[4];
#pragma unroll
        for (int i = 0; i < 4; ++i) gvr[i] = *(const GAS v4u*)(GV + (rowbase + srow + 32 * i) * AW + head * HC + c8 * 8);
        {
            const int row = tid >> 2; const GAS f32x4* sp = (const GAS f32x4*)(VST + (rowbase + row) * 32 + (tid & 3) * 8);
            float s = 0.f, qq = 0.f;
#pragma unroll
            for (int k = 0; k < 4; ++k) { const f32x4 v = sp[k]; s += v.x + v.z; qq += v.y + v.w; }
            s += __shfl_xor(s, 1); s += __shfl_xor(s, 2); qq += __shfl_xor(qq, 1); qq += __shfl_xor(qq, 2);
            if ((tid & 3) == 0) { const float mean = s * (1.f / AW), var = qq * (1.f / AW) - mean * mean; st[row] = mean; st[128 + row] = 1.f / sqrtf(var + NORM_EPS); }
        }
        __syncthreads();
#pragma unroll
        for (int i = 0; i < 4; ++i) {
            const int s = srow + 32 * i; const float mu = st[s], rs = st[128 + s]; const v4u g = gvr[i];
            const float f0 = (bflo(g.x) - mu) * rs * lg0.x + lb0.x, f1 = (bfhi(g.x) - mu) * rs * lg0.y + lb0.y, f2 = (bflo(g.y) - mu) * rs * lg0.z + lb0.z, f3 = (bfhi(g.y) - mu) * rs * lg0.w + lb0.w;
            const float f4 = (bflo(g.z) - mu) * rs * lg1.x + lb1.x, f5 = (bfhi(g.z) - mu) * rs * lg1.y + lb1.y, f6 = (bflo(g.w) - mu) * rs * lg1.z + lb1.z, f7 = (bfhi(g.w) - mu) * rs * lg1.w + lb1.w;
            const unsigned w0 = cvtpk(f0, f1), w1 = cvtpk(f2, f3), w2 = cvtpk(f4, f5), w3 = cvtpk(f6, f7);
            const bool sw = (s >> 3) & 1;
            v4u o; o.x = sw ? w2 : w0; o.y = sw ? w3 : w1; o.z = sw ? w0 : w2; o.w = sw ? w1 : w3;
            *(LAS v4u*)(vn + s * 256 + ((16 * c8) ^ ((s & 3) << 6))) = o;
        }
        v4u ur[4], zr[4];
        const size_t eoff = (rowbase + 16 * w + fr) * AW + head * HC + 8 * fq;
#pragma unroll
        for (int a = 0; a < 4; ++a) { ur[a] = *(const GAS v4u*)(UY + eoff + 32 * a); zr[a] = *(const GAS v4u*)(SZ + eoff + 32 * a); }
        __syncthreads();
        f32x4 acc[4][2];
#pragma unroll
        for (int a = 0; a < 4; ++a) { acc[a][0] = (f32x4){0.f, 0.f, 0.f, 0.f}; acc[a][1] = (f32x4){0.f, 0.f, 0.f, 0.f}; }
#pragma unroll
        for (int ks = 0; ks < 4; ++ks) {
            if (ks < 2 || w >= 4) {
#pragma unroll
                for (int a = 0; a < 4; ++a)
#pragma unroll
                    for (int t = 0; t < 2; ++t) {
                        const s16x4 lo = vtr(vn + rdb[a][t] + ks * 8192), hh = vtr(vn + rdb[a][t] + ks * 8192 + 1024);
                        const bf16x8 af = (bf16x8){lo[0], lo[1], lo[2], lo[3], hh[0], hh[1], hh[2], hh[3]};
                        acc[a][t] = __builtin_amdgcn_mfma_f32_16x16x32_bf16(af, wf[ks], acc[a][t], 0, 0, 0);
                    }
            }
        }
#pragma unroll
        for (int a = 0; a < 4; ++a) {
            const v4u u = ur[a], z = zr[a]; const f32x4 m0 = acc[a][0] + bias, m1 = acc[a][1] + bias;
            v4u o; o.x = cvtpk(bflo(u.x) * m0[0] * bflo(z.x), bfhi(u.x) * m0[1] * bfhi(z.x)); o.y = cvtpk(bflo(u.y) * m0[2] * bflo(z.y), bfhi(u.y) * m0[3] * bfhi(z.y));
            o.z = cvtpk(bflo(u.z) * m1[0] * bflo(z.z), bfhi(u.z) * m1[1] * bfhi(z.z)); o.w = cvtpk(bflo(u.w) * m1[2] * bflo(z.w), bfhi(u.w) * m1[3] * bfhi(z.w));
            *(GAS v4u*)(UY + eoff + 32 * a) = o;
        }
        __syncthreads();
    }
}
namespace att {
typedef float f32x16 __attribute__((ext_vector_type(16)));
constexpr int SLOTB = 8192;
constexpr int L_K = 0, L_V = 2 * SLOTB, L_WS = 4 * SLOTB, L_OST = L_WS + 8 * 256, L_BT = L_OST + 8 * 8192, L_END = L_BT + 2560;
static_assert(L_END <= RING_BYTES, "attention LDS map");
__device__ __forceinline__ int crow(int r, int hi) { return (r & 3) + 8 * (r >> 2) + 4 * hi; }
__device__ __forceinline__ void glds16(const void* gsrc, unsigned lds_dst) { unsigned keep;
    asm volatile("s_mov_b32 %0, m0\n\ts_mov_b32 m0, %2\n\ts_nop 0\n\tglobal_load_lds_dwordx4 %1, off\n\ts_mov_b32 m0, %0" : "=&s"(keep) : "v"(gsrc), "s"(lds_dst) : "memory"); }
#define ATT_WAIT_BAR() asm volatile("s_waitcnt vmcnt(0) lgkmcnt(0)\n\ts_barrier" ::: "memory")
template <int THR> __device__ __forceinline__ void attn_unit(const Ctx& F, int b, int h, int qb, const bf16* Q, const bf16* K, const bf16* V, const bf16* ZB, bf16* O, const float* relb) {
    const int tid = F.tid, lane = F.lane, r32 = lane & 31, hi = lane >> 5, wid = F.wave;
    LAS unsigned char* shm = F.lds + RING_OFF;
    const long rowbase = (long)b * SEQ; const int q0 = qb * 256, c0 = qb * 4, cw = c0 + (wid >> 1);
    LAS float* BT = (LAS float*)(shm + L_BT);
    LAS float* wsf = (LAS float*)(shm + L_WS) + wid * 64;
    for (int e = tid; e < 640; e += NWAVES * 64) { int rel = e - 63; rel = rel < -256 ? -256 : (rel > 256 ? 256 : rel); BT[e] = relb[h * NREL + rel + 256] * LOG2E; }
    const float cbias = relb[h * NREL + 512] * LOG2E;
    const bf16* Qw = Q + (rowbase + q0 + wid * 32) * D + h * HD;
    bf16x8 qr[4];
#pragma unroll
    for (int d0 = 0; d0 < 4; ++d0) qr[d0] = *(const GAS bf16x8*)(Qw + (long)r32 * D + d0 * 16 + hi * 8);
    const bf16* Kh = K + rowbase * D + h * HD; const bf16* Vh = V + rowbase * D + h * HD;
    const bf16* ksrc = Kh + (long)lane * D + wid * 8;
    const bf16* vsrc = Vh + (long)(16 * (wid & 3) + (lane >> 2)) * D + (wid >> 2) * 32 + (lane & 3) * 8;
    const unsigned lds0 = (unsigned)(uintptr_t)shm;
    const unsigned kdst = lds0 + L_K + wid * 1024, vdst = lds0 + L_V + wid * 1024;
#define DMA_K(t, slot) glds16(ksrc + (long)(t) * 64 * D, (unsigned)__builtin_amdgcn_readfirstlane(kdst + (slot)))
#define DMA_V(t, slot) glds16(vsrc + (long)(t) * 64 * D, (unsigned)__builtin_amdgcn_readfirstlane(vdst + (slot)))
    float m = -1e30f, l = 0.f; f32x16 o[2];
#pragma unroll
    for (int r = 0; r < 16; ++r) { o[0][r] = 0.f; o[1][r] = 0.f; }
    const int jlo = c0 - 8 < 0 ? 0 : c0 - 8, jhi = c0 + 3;
    DMA_K(jlo, 0); DMA_V(jlo, 0);
    int slot = 0;
    for (int j = jlo; j <= jhi; ++j) {
        ATT_WAIT_BAR();
        if (j < jhi) { DMA_K(j + 1, slot ^ SLOTB); DMA_V(j + 1, slot ^ SLOTB); }
        const int dj = cw - j;
        if (dj >= 0 && dj <= 8) {
            f32x16 p0, p1;
            { const LAS unsigned char* kp = shm + L_K + slot + hi * 1024 + r32 * 16;
#pragma unroll
              for (int d0 = 0; d0 < 4; ++d0) {
                  const bf16x8 b0 = *(const LAS bf16x8*)(kp + d0 * 2048), b1 = *(const LAS bf16x8*)(kp + d0 * 2048 + 512);
                  if (d0 == 0) { f32x16 z; for (int r = 0; r < 16; ++r) z[r] = 0.f; p0 = __builtin_amdgcn_mfma_f32_32x32x16_bf16(b0, qr[0], z, 0, 0, 0); p1 = __builtin_amdgcn_mfma_f32_32x32x16_bf16(b1, qr[0], z, 0, 0, 0); }
                  else { p0 = __builtin_amdgcn_mfma_f32_32x32x16_bf16(b0, qr[d0], p0, 0, 0, 0); p1 = __builtin_amdgcn_mfma_f32_32x32x16_bf16(b1, qr[d0], p1, 0, 0, 0); } } }
            if (dj <= 4) {
                const LAS float* bp = BT + (64 * dj + 32 * (wid & 1) + r32 + 63 - 4 * hi);
#pragma unroll
                for (int r = 0; r < 16; ++r) { const int kv = (r & 3) + 8 * (r >> 2); p0[r] += bp[-kv]; p1[r] += bp[-32 - kv]; }
            } else {
#pragma unroll
                for (int r = 0; r < 16; ++r) { p0[r] += cbias; p1[r] += cbias; }
            }
            float rm = fmaxf(p0[0], p1[0]);
#pragma unroll
            for (int r = 1; r < 16; ++r) rm = fmaxf(rm, fmaxf(p0[r], p1[r]));
            { auto rr = __builtin_amdgcn_permlane32_swap(__float_as_uint(rm), __float_as_uint(rm), false, false); rm = fmaxf(__uint_as_float(rr[0]), __uint_as_float(rr[1])); }
            if (__any(rm > m + (float)THR)) {
                const float mn = fmaxf(m, rm), f = __builtin_amdgcn_exp2f(m - mn); l *= f; m = mn;
                if (hi == 0) wsf[r32] = f;
#pragma unroll
                for (int r = 0; r < 16; ++r) { const float fr_ = wsf[crow(r, hi)]; o[0][r] *= fr_; o[1][r] *= fr_; }
            }
            float sacc = 0.f;
#pragma unroll
            for (int r = 0; r < 16; ++r) { p0[r] = __builtin_amdgcn_exp2f(p0[r] - m); p1[r] = __builtin_amdgcn_exp2f(p1[r] - m); sacc += p0[r] + p1[r]; }
            l += sacc;
            bf16x8 pa[4];
            { v4u t0 = {cvtpk(p0[0], p0[1]), cvtpk(p0[2], p0[3]), cvtpk(p0[4], p0[5]), cvtpk(p0[6], p0[7])}; pa[0] = __builtin_bit_cast(bf16x8, t0);
              v4u t1 = {cvtpk(p0[8], p0[9]), cvtpk(p0[10], p0[11]), cvtpk(p0[12], p0[13]), cvtpk(p0[14], p0[15])}; pa[1] = __builtin_bit_cast(bf16x8, t1);
              v4u t2 = {cvtpk(p1[0], p1[1]), cvtpk(p1[2], p1[3]), cvtpk(p1[4], p1[5]), cvtpk(p1[6], p1[7])}; pa[2] = __builtin_bit_cast(bf16x8, t2);
              v4u t3 = {cvtpk(p1[8], p1[9]), cvtpk(p1[10], p1[11]), cvtpk(p1[12], p1[13]), cvtpk(p1[14], p1[15])}; pa[3] = __builtin_bit_cast(bf16x8, t3); }
            const LAS unsigned char* vp = shm + L_V + slot + ((lane >> 4) & 1) * 32 + (lane & 3) * 8 + (4 * hi + ((lane & 15) >> 2)) * 64;
#pragma unroll
            for (int d0 = 0; d0 < 2; ++d0)
#pragma unroll
                for (int ks = 0; ks < 4; ++ks) {
                    const s16x4 lo = vtr(vp + d0 * 4096 + ks * 1024), hh = vtr(vp + d0 * 4096 + ks * 1024 + 512);
                    const bf16x8 vf = (bf16x8){lo[0], lo[1], lo[2], lo[3], hh[0], hh[1], hh[2], hh[3]};
                    o[d0] = __builtin_amdgcn_mfma_f32_32x32x16_bf16(pa[ks], vf, o[d0], 0, 0, 0);
                }
        }
        slot ^= SLOTB;
    }
    { auto rr = __builtin_amdgcn_permlane32_swap(__float_as_uint(l), __float_as_uint(l), false, false); l = __uint_as_float(rr[0]) + __uint_as_float(rr[1]); }
    if (hi == 0) wsf[r32] = 1.f / l;
    LAS float* stg = (LAS float*)(shm + L_OST) + wid * 2048;
#pragma unroll
    for (int r = 0; r < 16; ++r) { const int orow = crow(r, hi); const float rl = wsf[orow]; stg[orow * 64 + r32] = o[0][r] * rl; stg[orow * 64 + 32 + r32] = o[1][r] * rl; }
    const size_t orow0 = (size_t)(rowbase + q0 + wid * 32);
#pragma unroll
    for (int i = 0; i < 4; ++i) { const int row = i * 8 + (lane >> 3), ch = lane & 7;
        const f32x4 a0 = *(const LAS f32x4*)(stg + row * 64 + ch * 8), a1 = *(const LAS f32x4*)(stg + row * 64 + ch * 8 + 4);
        const v4u z = *(const GAS v4u*)(ZB + (orow0 + row) * D + h * HD + ch * 8);
        v4u ov; ov.x = cvtpk(a0[0] * bflo(z.x), a0[1] * bfhi(z.x)); ov.y = cvtpk(a0[2] * bflo(z.y), a0[3] * bfhi(z.y)); ov.z = cvtpk(a1[0] * bflo(z.z), a1[1] * bfhi(z.z)); ov.w = cvtpk(a1[2] * bflo(z.w), a1[3] * bfhi(z.w));
        *(GAS v4u*)(O + (orow0 + row) * D + h * HD + ch * 8) = ov; }
    ATT_WAIT_BAR();
#undef DMA_K
#undef DMA_V
}
__device__ __forceinline__ void attn_phase(const Ctx& F, const bf16* Q, const bf16* K, const bf16* V, const bf16* ZB, bf16* O, const float* relb) {
    for (int n = F.vcu; n < 4 * BH * (SEQ / 256); n += F.G) {
        const int bh = (n & 255) >> 2, qb = (n & 3) + 4 * (n >> 8);
        attn_unit<8>(F, bh >> 4, bh & 15, qb, Q, K, V, ZB, O, relb);
    }
}
}
#ifndef N_LAUNCHES
#define N_LAUNCHES 1
#endif
#ifndef SIMPLE_MIX
#define SIMPLE_MIX 0
#endif
#ifndef SIMPLE_ATT
#define SIMPLE_ATT 0
#endif
enum { PH_PRO = 0, PH_G1 = 1, PH_MIX = 2, PH_G2 = 3, PH_G3 = 4, PH_ATT = 5, PH_G4 = 6, PH_FIN = 7, PH_N = 8 };
struct Args { const float* in[15]; float* out; unsigned char* ws; int ph_lo, ph_hi; };
__global__ void __launch_bounds__(NWAVES * 64, 2) fwd(Args args) {
    extern __shared__ __attribute__((aligned(16))) unsigned char lds[];
    Ctx F;
    F.lds = (LAS unsigned char*)lds;
    F.tid = threadIdx.x; F.lane = F.tid & 63; F.wave = __builtin_amdgcn_readfirstlane(F.tid >> 6);
    F.G = gridDim.x; { const int bx = blockIdx.x; F.vcu = (F.G % 8 == 0) ? (bx % 8) * (F.G / 8) + bx / 8 : bx; }
    volatile LAS unsigned* MISC = (volatile LAS unsigned*)(F.lds + MISC_OFF);
    unsigned char* ws = args.ws;
    gu32* ctl = (gu32*)(ws + WS_CTL);
    const float* x = args.in[0]; float* out = args.out;
    bf16* WIN = (bf16*)(ws + WS_WIN); bf16* WAOUT = (bf16*)(ws + WS_WAOUT); bf16* WKVQZ = (bf16*)(ws + WS_WKVQZ); bf16* WBOUT = (bf16*)(ws + WS_WBOUT); bf16* WM = (bf16*)(ws + WS_WM);
    bf16* XN = (bf16*)(ws + WS_XN); bf16* U = (bf16*)(ws + WS_U); bf16* GV = (bf16*)(ws + WS_GV); bf16* SZ = (bf16*)(ws + WS_SZ);
    bf16* KB = (bf16*)(ws + WS_K); bf16* QO = (bf16*)(ws + WS_Q);
    float* SS1 = (float*)(ws + WS_SS1); float* SS2 = (float*)(ws + WS_SS2);
    const int lo = args.ph_lo, hi = args.ph_hi;
    const bool multi = (hi - lo) > 1;
    for (int u = F.tid; u < (LDS_BYTES - LDSCTL_OFF) / 4; u += NWAVES * 64) ((LAS unsigned*)(F.lds + LDSCTL_OFF))[u] = 0u;
    __syncthreads();
    XcdBarrier bar; bar.bar = (unsigned*)(ctl + CW_BAR); bar.x = 0; bar.st = nullptr;
    if (multi) bar = xcd_barrier_post((unsigned*)(ctl + CW_BAR), MISC + 8);
#define IN(k) (lo <= (k) && (k) < hi)
#define SEAM(k) do { if (IN(k) && IN((k) + 1)) xcd_barrier(bar); } while (0)

    if (IN(PH_PRO)) {
        P0Args a{x, args.in[1], args.in[2], args.in[5], args.in[7], args.in[8], args.in[9], args.in[10], args.in[11], args.in[13], WIN, WAOUT, WKVQZ, WBOUT, WM, XN};
        p0_prologue(F, a);
    }
    SEAM(PH_PRO);
    if (IN(PH_G1)) {
        pg8::Gemm g{XN, WIN, M, NIN, D}; pg8::StaticOrder S; S.init(M, NIN, F.G, (int)blockIdx.x);
        pg8::EpiAct1 E{U, GV, SZ, (pg8::f32x2e*)(ws + WS_VST)};
        pg8::gemm_phase<pg8::EpiAct1, pg8::StaticOrder, PG8_ALIGN, PG8_SP2>(F.lds + RING_OFF, g, S, E);
    }
    SEAM(PH_G1);
    if (IN(PH_MIX)) p2_mix(F, GV, U, SZ, (const f32x2*)(ws + WS_VST), WM, args.in[3], args.in[4], args.in[6]);
    SEAM(PH_MIX);
    if (IN(PH_G2)) {
        pg8::Gemm g{U, WAOUT, M, D, AW}; pg8::StaticOrder S; S.init(M, D, F.G, (int)blockIdx.x);
        pg8::EpiRes<true> E{x, out, XN, SS1};
        pg8::gemm_phase<pg8::EpiRes<true>, pg8::StaticOrder, PG8_ALIGN, PG8_SP2>(F.lds + RING_OFF, g, S, E);
    }
    SEAM(PH_G2);
    if (IN(PH_G3)) {
        pg8::Gemm g{XN, WKVQZ, M, 4096, D}; pg8::StaticOrder S; S.init(M, 4096, F.G, (int)blockIdx.x);
        pg8::EpiKVQZ E{KB, SS1, QSCALE};
        pg8::gemm_phase<pg8::EpiKVQZ, pg8::StaticOrder, PG8_ALIGN, PG8_SP2>(F.lds + RING_OFF, g, S, E);
    }
    SEAM(PH_G3);
    if (IN(PH_ATT)) att::attn_phase(F, QO, KB, (const bf16*)(ws + WS_V), (const bf16*)(ws + WS_ZB), QO, args.in[12]);
    SEAM(PH_ATT);
    if (IN(PH_G4)) {
        pg8::Gemm g{QO, WBOUT, M, D, D}; pg8::StaticOrder S; S.init(M, D, F.G, (int)blockIdx.x);
        pg8::EpiRes<false> E{out, out, nullptr, SS2};
        pg8::gemm_phase<pg8::EpiRes<false>, pg8::StaticOrder, PG8_ALIGN, PG8_SP2>(F.lds + RING_OFF, g, S, E);
    }
    SEAM(PH_G4);
    if (IN(PH_FIN)) p7_final(F, out, SS2, args.in[14]);
#undef IN
#undef SEAM
}

extern "C" void kernel_launch(void* const* d_in, const int* in_sizes, int n_in, void* d_out, int out_size, void* d_ws, size_t ws_size, hipStream_t stream) {
    static int grid = 0;
    if (grid == 0) {
        if (n_in != 15 || in_sizes[0] != M * D || out_size != M * D || ws_size < WS_END) { fprintf(stderr, "kernel_launch: unexpected shapes (n_in %d in0 %d out %d ws %zu)\n", n_in, n_in > 0 ? in_sizes[0] : -1, out_size, ws_size); grid = -1; return; }
        int dev = 0, cus = 0, per_cu = 0;
        if (hipGetDevice(&dev) != hipSuccess || hipDeviceGetAttribute(&cus, hipDeviceAttributeMultiprocessorCount, dev) != hipSuccess) { grid = -1; return; }
        if (hipFuncSetAttribute((const void*)fwd, hipFuncAttributeMaxDynamicSharedMemorySize, LDS_BYTES) != hipSuccess) { fprintf(stderr, "kernel_launch: hipFuncSetAttribute failed\n"); grid = -1; return; }
        if (hipOccupancyMaxActiveBlocksPerMultiprocessor(&per_cu, (const void*)fwd, NWAVES * 64, LDS_BYTES) != hipSuccess || per_cu < 1) { fprintf(stderr, "kernel_launch: occupancy query says %d\n", per_cu); per_cu = 1; }
        (void)hipGetLastError();
        grid = cus;
    }
    if (grid < 0) return;
    (void)hipMemsetAsync((char*)d_ws + WS_CTL, 0, CTL_ZERO_BYTES, stream);
    Args a{};
    for (int i = 0; i < 15; ++i) a.in[i] = (const float*)d_in[i];
    a.out = (float*)d_out; a.ws = (unsigned char*)d_ws;
    unsigned char* ws = (unsigned char*)d_ws;
    auto run = [&](int lo, int hi) { a.ph_lo = lo; a.ph_hi = hi; hipLaunchKernelGGL(fwd, dim3(grid), dim3(NWAVES * 64), LDS_BYTES, stream, a); };
#if N_LAUNCHES == 1
    run(PH_PRO, PH_N);
#else
    for (int ph = 0; ph < PH_N; ++ph) run(ph, ph + 1);
#endif
}
```
